# Optimizing an MI355X kernel written in HIP

```python
import math
import jax
import jax.numpy as jnp
from jax import lax
import numpy as np

D_MODEL = 1024
BATCH = 8
SEQ = 4096
DEPTH = 2

HEAD_DIM = D_MODEL // 16
NSA_HEADS = 6
NSA_KV_GROUPS = 2
NSA_HPG = NSA_HEADS // NSA_KV_GROUPS
CMP_BLOCK = 32
CMP_STRIDE = 16
CMP_HIDDEN = 2 * HEAD_DIM
SLC_BLOCK = 64
SLC_TOPN = 16
WINDOW = 512
NSA_QBLOCK = 64
FORCE_BONUS = 1000.0
NEG_BIG = -1e30
LB_FLOOR = 1e-30
SB_HEADS = 4
SB_QBLOCK = 128
HG_HEADS = 6
HG_KDIM = HEAD_DIM
HG_VDIM = HEAD_DIM
HG_CHUNK = 64
NUM_BUCKETS = 32
MAX_DISTANCE = 128
D_NSA = NSA_HEADS * HEAD_DIM
D_KV = NSA_KV_GROUPS * HEAD_DIM
D_SB = SB_HEADS * HEAD_DIM
D_HG = HG_HEADS * HG_VDIM
D_MIX = D_NSA + D_SB + D_HG
N_GATES = NSA_HEADS * 3
SPLIT_SIZES = (D_NSA, D_KV, D_KV, D_KV, D_KV, D_KV, D_KV, N_GATES, D_NSA,
               D_SB, D_SB, D_SB, D_SB,
               HG_HEADS * HG_KDIM, HG_HEADS * HG_KDIM, D_HG, D_HG)
D_IN = sum(SPLIT_SIZES)
ALPHA = (2 * DEPTH) ** 0.25
OUT_INIT_SCALE = (8 * DEPTH) ** -0.25
LN_EPS = 1e-5
RMS_EPS = 1e-6

kernel_name = 'hybrid_nsa_stickbreak_hgrn2_deepnorm'


def t5_bucket(rel):
    n = jnp.maximum(rel, 0)
    max_exact = NUM_BUCKETS // 2
    large = max_exact + (jnp.log(jnp.maximum(n, 1).astype(jnp.float32) / max_exact)
                         / math.log(MAX_DISTANCE / max_exact)
                         * (NUM_BUCKETS - max_exact)).astype(jnp.int32)
    large = jnp.clip(large, 0, NUM_BUCKETS - 1)
    return jnp.where(n < max_exact, n, large)


def masked_softmax(s, mask):
    s = jnp.where(mask, s.astype(jnp.float32), NEG_BIG)
    p = jax.nn.softmax(s, axis=-1)
    return jnp.where(mask, p, 0.0)


def layer_norm(v, g, b):
    v32 = v.astype(jnp.float32)
    mu = jnp.mean(v32, axis=-1, keepdims=True)
    var = jnp.mean(jnp.square(v32 - mu), axis=-1, keepdims=True)
    return ((v32 - mu) * lax.rsqrt(var + LN_EPS) * g + b).astype(v.dtype)


def nsa_mixer(q, kc_src, vc_src, ks_src, vs_src, kw_src, vw_src, gate_logits,
              cmp_pos, w_ck1, w_ck2, w_cv1, w_cv2, rel_bias):
    B, S = q.shape[:2]
    G, HPG, dk, QB = NSA_KV_GROUPS, NSA_HPG, HEAD_DIM, NSA_QBLOCK
    scale = 1.0 / math.sqrt(dk)
    q = q.reshape(B, S, G, HPG, dk).transpose(0, 2, 3, 1, 4)
    gates = jax.nn.sigmoid(gate_logits.reshape(B, S, G, HPG, 3).transpose(0, 2, 3, 1, 4))

    n_cmp = (S - CMP_BLOCK) // CMP_STRIDE + 1
    blk_idx = np.arange(n_cmp)[:, None] * CMP_STRIDE + np.arange(CMP_BLOCK)[None, :]

    def compress(src, w1, w2):
        blocks = src.reshape(B, S, G, dk)[:, blk_idx] + cmp_pos[None, None, :, None, :]
        blocks = blocks.transpose(0, 3, 1, 2, 4).reshape(B, G, n_cmp, CMP_BLOCK * dk)
        return jax.nn.gelu(blocks @ w1) @ w2

    kc = compress(kc_src, w_ck1, w_ck2)
    vc = compress(vc_src, w_cv1, w_cv2)
    cmp_start = np.arange(n_cmp) * CMP_STRIDE
    cmp_end = jnp.asarray(cmp_start + CMP_BLOCK - 1, dtype=jnp.int32)

    n_slc = S // SLC_BLOCK
    topn = min(SLC_TOPN, n_slc)
    slc_start = np.arange(n_slc) * SLC_BLOCK
    overlap = jnp.asarray(((cmp_start[:, None] < slc_start[None, :] + SLC_BLOCK)
                           & (cmp_start[:, None] + CMP_BLOCK > slc_start[None, :])).astype(np.float32))
    ks = ks_src.reshape(B, S, G, dk).transpose(0, 2, 1, 3).reshape(B, G, n_slc, SLC_BLOCK, dk)
    vs = vs_src.reshape(B, S, G, dk).transpose(0, 2, 1, 3).reshape(B, G, n_slc, SLC_BLOCK, dk)

    pad = ((0, 0), (0, 0), (WINDOW, 0), (0, 0))
    kw = jnp.pad(kw_src.reshape(B, S, G, dk).transpose(0, 2, 1, 3), pad)
    vw = jnp.pad(vw_src.reshape(B, S, G, dk).transpose(0, 2, 1, 3), pad)

    tbl = rel_bias.reshape(NUM_BUCKETS, G, HPG)
    tbl_g = tbl.transpose(1, 0, 2)
    b_ix = jnp.arange(B)[:, None, None, None]
    g_ix = jnp.arange(G)[None, :, None, None]
    blk = jnp.arange(n_slc)

    def block(i):
        t0 = i * QB
        t = t0 + jnp.arange(QB)
        qb = lax.dynamic_slice_in_dim(q, t0, QB, axis=3)
        gb = lax.dynamic_slice_in_dim(gates, t0, QB, axis=3)

        rel_c = t[:, None] - cmp_end[None, :]
        bias_c = tbl[t5_bucket(rel_c)].transpose(2, 3, 0, 1)
        s_c = jnp.einsum('bghtd,bgnd->bghtn', qb, kc) * scale + bias_c
        p_c = masked_softmax(s_c, rel_c >= 0)
        o_c = jnp.einsum('bghtn,bgnd->bghtd', p_c.astype(vc.dtype), vc)

        imp = jnp.einsum('bghtn,nj->bgtj', p_c, overlap)
        cur = t // SLC_BLOCK
        forced = (blk[None, :] == 0) | (blk[None, :] == cur[:, None]) | (blk[None, :] == cur[:, None] - 1)
        valid = blk[None, :] * SLC_BLOCK <= t[:, None]
        score = jnp.where(valid, imp + FORCE_BONUS * forced.astype(jnp.float32), NEG_BIG)
        _, idx = lax.top_k(score, topn)
        k_sel = ks[b_ix, g_ix, idx].reshape(B, G, QB, topn * SLC_BLOCK, dk)
        v_sel = vs[b_ix, g_ix, idx].reshape(B, G, QB, topn * SLC_BLOCK, dk)
        pos = (idx[..., None] * SLC_BLOCK + jnp.arange(SLC_BLOCK)).reshape(B, G, QB, topn * SLC_BLOCK)
        rel_s = t[:, None] - pos
        bias_s = jnp.moveaxis(tbl_g[g_ix, t5_bucket(rel_s)], -1, 2)
        s_s = jnp.einsum('bghtd,bgtkd->bghtk', qb, k_sel) * scale + bias_s
        p_s = masked_softmax(s_s, (rel_s >= 0)[:, :, None])
        o_s = jnp.einsum('bghtk,bgtkd->bghtd', p_s.astype(v_sel.dtype), v_sel)

        kwb = lax.dynamic_slice_in_dim(kw, t0, WINDOW + QB, axis=2)
        vwb = lax.dynamic_slice_in_dim(vw, t0, WINDOW + QB, axis=2)
        pos_w = t0 - WINDOW + jnp.arange(WINDOW + QB)
        rel_w = t[:, None] - pos_w[None, :]
        mask_w = (rel_w >= 0) & (rel_w < WINDOW) & (pos_w[None, :] >= 0)
        bias_w = tbl[t5_bucket(rel_w)].transpose(2, 3, 0, 1)
        s_w = jnp.einsum('bghtd,bgkd->bghtk', qb, kwb) * scale + bias_w
        p_w = masked_softmax(s_w, mask_w)
        o_w = jnp.einsum('bghtk,bgkd->bghtd', p_w.astype(vwb.dtype), vwb)

        return gb[..., 0:1] * o_c + gb[..., 1:2] * o_s + gb[..., 2:3] * o_w

    o = lax.map(block, jnp.arange(S // QB))
    return o.transpose(1, 0, 4, 2, 3, 5).reshape(B, S, D_NSA)


def stick_breaking_mixer(q, k, v):
    B, S = q.shape[:2]
    H, dk, QB = SB_HEADS, HEAD_DIM, SB_QBLOCK
    scale = 1.0 / math.sqrt(dk)
    q = q.reshape(B, S, H, dk).transpose(0, 2, 1, 3)
    k = k.reshape(B, S, H, dk).transpose(0, 2, 1, 3)
    v = v.reshape(B, S, H, dk).transpose(0, 2, 1, 3)
    s_idx = jnp.arange(S)

    def block(i):
        t0 = i * QB
        t = t0 + jnp.arange(QB)
        qb = lax.dynamic_slice_in_dim(q, t0, QB, axis=2)
        z = jnp.einsum('bhtd,bhsd->bhts', qb, k).astype(jnp.float32) * scale
        mask = s_idx[None, :] < t[:, None]
        log_rest = jnp.where(mask, jax.nn.log_sigmoid(-z), 0.0)
        rcs = lax.cumsum(log_rest, axis=3, reverse=True)
        between = jnp.pad(rcs[..., 1:], ((0, 0), (0, 0), (0, 0), (0, 1)))
        log_a = jnp.where(mask, jax.nn.log_sigmoid(z) + between, 0.0)
        a = jnp.where(mask, jnp.exp(log_a), 0.0)
        return jnp.einsum('bhts,bhsd->bhtd', a.astype(v.dtype), v)

    o = lax.map(block, jnp.arange(S // QB))
    return o.transpose(1, 0, 3, 2, 4).reshape(B, S, D_SB)


def hgrn2_mixer(q, f_logit, i_val, lb):
    B, S = q.shape[:2]
    H, dk, dv, C = HG_HEADS, HG_KDIM, HG_VDIM, HG_CHUNK
    n_c = S // C
    f32 = f_logit.astype(jnp.float32)
    log_f = jnp.logaddexp(jnp.log(jnp.maximum(lb, LB_FLOOR)), jnp.log1p(-lb) + jax.nn.log_sigmoid(f32))
    key = (1.0 - lb) * jax.nn.sigmoid(-f32)

    def heads(a, d):
        return a.astype(jnp.float32).reshape(B, n_c, C, H, d).transpose(1, 0, 3, 2, 4)

    qc, kc, lfc, vc = heads(q, dk), heads(key, dk), heads(log_f, dk), heads(i_val, dv)
    causal = jnp.asarray(np.tril(np.ones((C, C), dtype=bool)))[None, None, :, :, None]

    def step(state, inp):
        qx, kx, lf, vx = inp
        b = jnp.cumsum(lf, axis=2)
        diff = b[:, :, :, None, :] - b[:, :, None, :, :]
        decay = jnp.where(causal, jnp.exp(jnp.where(causal, diff, 0.0)), 0.0)
        att = jnp.einsum('bhtd,bhsd,bhtsd->bhts', qx, kx, decay)
        o = att @ vx + jnp.einsum('bhtd,bhde->bhte', qx * jnp.exp(b), state)
        b_last = b[:, :, -1:, :]
        state = (jnp.exp(b_last[:, :, 0, :])[..., None] * state
                 + jnp.einsum('bhsd,bhse->bhde', kx * jnp.exp(b_last - b), vx))
        return state, o

    s0 = jnp.zeros((B, H, dk, dv), jnp.float32)
    _, o = lax.scan(step, s0, (qc, kc, lfc, vc))
    return o.transpose(1, 0, 3, 2, 4).reshape(B, S, H, dv)


def setup_inputs(seed: int = 0) -> dict:
    key = jax.random.key(seed)
    ks = jax.random.split(key, 13)

    def nrm(k, shape, scale):
        return jax.random.normal(k, shape, jnp.float32) * scale

    x = nrm(ks[0], (BATCH, SEQ, D_MODEL), 1.0)
    w_in = nrm(ks[1], (DEPTH, D_MODEL, D_IN), D_MODEL ** -0.5)
    cmp_pos = nrm(ks[2], (DEPTH, CMP_BLOCK, HEAD_DIM), 0.1)
    w_ck1 = nrm(ks[3], (DEPTH, CMP_BLOCK * HEAD_DIM, CMP_HIDDEN), (CMP_BLOCK * HEAD_DIM) ** -0.5)
    w_ck2 = nrm(ks[4], (DEPTH, CMP_HIDDEN, HEAD_DIM), CMP_HIDDEN ** -0.5)
    w_cv1 = nrm(ks[5], (DEPTH, CMP_BLOCK * HEAD_DIM, CMP_HIDDEN), (CMP_BLOCK * HEAD_DIM) ** -0.5)
    w_cv2 = nrm(ks[6], (DEPTH, CMP_HIDDEN, HEAD_DIM), CMP_HIDDEN ** -0.5)
    hg_lb = nrm(ks[7], (DEPTH, HG_HEADS * HG_KDIM), 0.5)
    hg_norm_w = 1.0 + nrm(ks[8], (DEPTH, D_HG), 0.05)
    w_out = nrm(ks[9], (DEPTH, D_MIX, D_MODEL), D_MIX ** -0.5 * OUT_INIT_SCALE)
    ln_g = 1.0 + nrm(ks[10], (DEPTH, D_MODEL), 0.05)
    ln_b = nrm(ks[11], (DEPTH, D_MODEL), 0.02)
    rel_bias = nrm(ks[12], (NUM_BUCKETS, NSA_HEADS), 0.5)
    return {'x': x, 'w_in': w_in, 'cmp_pos': cmp_pos, 'w_ck1': w_ck1, 'w_ck2': w_ck2,
            'w_cv1': w_cv1, 'w_cv2': w_cv2, 'hg_lb': hg_lb, 'hg_norm_w': hg_norm_w,
            'w_out': w_out, 'ln_g': ln_g, 'ln_b': ln_b, 'rel_bias': rel_bias}


def reference(x, w_in, cmp_pos, w_ck1, w_ck2, w_cv1, w_cv2, hg_lb, hg_norm_w,
              w_out, ln_g, ln_b, rel_bias):
    lb_w = jax.nn.softmax(hg_lb.astype(jnp.float32), axis=0)
    lb_all = jnp.cumsum(lb_w, axis=0) - lb_w[0]
    offsets = np.cumsum(SPLIT_SIZES)[:-1].tolist()
    for l in range(DEPTH):
        h = x @ w_in[l]
        (nsa_q, nsa_kc, nsa_vc, nsa_ks, nsa_vs, nsa_kw, nsa_vw, nsa_g, nsa_z,
         sb_q, sb_k, sb_v, sb_z, hg_q, hg_f, hg_i, hg_z) = jnp.split(h, offsets, axis=-1)
        o_nsa = nsa_mixer(nsa_q, nsa_kc, nsa_vc, nsa_ks, nsa_vs, nsa_kw, nsa_vw, nsa_g,
                          cmp_pos[l], w_ck1[l], w_ck2[l], w_cv1[l], w_cv2[l], rel_bias)
        o_sb = stick_breaking_mixer(sb_q, sb_k, sb_v)
        o_hg = hgrn2_mixer(hg_q, hg_f, hg_i, lb_all[l])
        o_hg = o_hg * lax.rsqrt(jnp.mean(jnp.square(o_hg), axis=-1, keepdims=True) + RMS_EPS)
        o_hg = (o_hg * hg_norm_w[l].reshape(HG_HEADS, HG_VDIM)).reshape(o_hg.shape[0], o_hg.shape[1], D_HG)
        mixed = jnp.concatenate([o_nsa * jax.nn.silu(nsa_z),
                                 o_sb * jax.nn.silu(sb_z),
                                 o_hg.astype(x.dtype) * jax.nn.silu(hg_z)], axis=-1)
        x = layer_norm(ALPHA * x + (mixed @ w_out[l]).astype(x.dtype), ln_g[l], ln_b[l])
    return x
```

```cpp
#include <hip/hip_runtime.h>
#include <hip/hip_cooperative_groups.h>
#include <cstdio>
#include <cstdint>
namespace cg = cooperative_groups;

#define LAS __attribute__((address_space(3)))
typedef _Float16 h16;
typedef _Float16 h16x8 __attribute__((ext_vector_type(8)));
typedef _Float16 h16x4 __attribute__((ext_vector_type(4)));
typedef _Float16 h16x2 __attribute__((ext_vector_type(2)));
typedef short s16x4 __attribute__((ext_vector_type(4)));
typedef float f32x2 __attribute__((ext_vector_type(2)));
typedef float f32x4 __attribute__((ext_vector_type(4)));
typedef unsigned u32x4 __attribute__((ext_vector_type(4)));
typedef float f32x16 __attribute__((ext_vector_type(16)));
typedef unsigned u32x2 __attribute__((ext_vector_type(2)));

constexpr int NB = 8, SEQ = 4096, DM = 1024, MTOK = NB * SEQ, DEPTH = 2;
constexpr int DIN = 4114, NH = 4352;
constexpr int C_NQ = 0, C_KC = 384, C_VC = 512, C_KS = 640, C_VS = 768, C_KW = 896, C_VW = 1024, C_NZ = 1152;
constexpr int C_SQ = 1536, C_SK = 1792, C_SV = 2048, C_SZ = 2304, C_HQ = 2560, C_HF = 2944, C_HI = 3328, C_HZ = 3712, C_G = 4096;
constexpr float ALPHA = 1.4142135623730951f;
constexpr int NCHUNK = 64;
constexpr int HG_G = 8;

constexpr size_t MiB = 1u << 20;
constexpr size_t WS_CTL = 0;
constexpr size_t CTL_BYTES = 4096;
constexpr size_t WS_WINT = 2 * MiB;
constexpr size_t WS_WOUTT = 20 * MiB;
constexpr size_t WS_WC1T = 24 * MiB;
constexpr size_t WS_WC2T = 26 * MiB;
constexpr size_t WS_PBP = 26 * MiB + 512 * 1024;
constexpr size_t WS_KC = 27 * MiB;
constexpr size_t WS_VCT = 27 * MiB + 512 * 1024;
constexpr size_t WS_HGU = 28 * MiB;
constexpr size_t WS_HGD = 79 * MiB;
constexpr size_t WS_XH = 80 * MiB;
constexpr size_t WS_MIX = 144 * MiB;
constexpr size_t WS_H = 208 * MiB;
constexpr size_t WS_END = 480 * MiB;

struct Params { const float* in[13]; float* out; unsigned char* ws; };

__device__ __forceinline__ unsigned pk2h(float a, float b) { h16x2 v = {(h16)a, (h16)b}; return __builtin_bit_cast(unsigned, v); }
__device__ __forceinline__ float wave_sum(float v) {
#pragma unroll
    for (int o = 1; o < 64; o <<= 1) v += __shfl_xor(v, o);
    return v;
}
__device__ __forceinline__ float xhalf(float x, int hi) {
    auto r = __builtin_amdgcn_permlane32_swap(__float_as_uint(x), __float_as_uint(x), false, false);
    return __uint_as_float(hi ? r[0] : r[1]);
}
__device__ __forceinline__ f32x16 mfma32(h16x8 a, h16x8 b, f32x16 c) { return __builtin_amdgcn_mfma_f32_32x32x16_f16(a, b, c, 0, 0, 0); }
__device__ __forceinline__ f32x4 mfma16(h16x8 a, h16x8 b, f32x4 c) { return __builtin_amdgcn_mfma_f32_16x16x32_f16(a, b, c, 0, 0, 0); }
__device__ __forceinline__ int crow(int r, int hi) { return (r & 3) + 8 * (r >> 2) + 4 * hi; }
namespace pg8 {
#define PG8_LAS __attribute__((address_space(3)))
typedef unsigned short bf16_t;
typedef short bf16x8 __attribute__((ext_vector_type(8)));
typedef float f32x4 __attribute__((ext_vector_type(4)));
typedef unsigned u32x4 __attribute__((ext_vector_type(4)));
constexpr int BM = 256, BK = 64, HALF = 128, HTB = HALF * BK * 2  , STAGE_BYTES = 8 * HTB, NXCD = 8, WGM = 8;

__host__ __device__ __forceinline__ int lds_byte(int r, int c) { const int st = (r >> 4) * 2 + (c >> 5), rr = r & 15, cc = c & 31, ob = rr * 64 + cc * 2; return st * 1024 + (ob ^ (((ob >> 9) & 1) << 5)); }
__host__ __device__ __forceinline__ void stage_rc(int b, int& R, int& C) { const int st = b / 1024, sb = b % 1024, swz = sb ^ (((sb >> 9) & 1) << 5); R = (st >> 1) * 16 + swz / 64; C = (st & 1) * 32 + (swz % 64) / 2; }
__host__ __device__ __forceinline__ int perm32(int rho) { const int n = rho >> 4, i = rho & 15; return 8 * (i >> 2) + 4 * n + (i & 3); }

struct Unit { int pm, pn; };
struct Gemm { const bf16_t* A; const bf16_t* Bt; int M, N, K; };

struct StaticOrder {
    int nM, nN, nwg, G, c;
    __host__ __device__ void init(int M, int N, int G_, int c_) { nM = M / BM; nN = N / BM; nwg = nM * nN; G = G_; c = c_; }
    __host__ __device__ bool next(int i, Unit& u) const {
        const long L = (long)i * G + c; if (L >= nwg) return false;
        int wgid = (int)L; { const int q = nwg / NXCD, r = nwg % NXCD, xcd = wgid % NXCD, off = wgid / NXCD; wgid = (xcd < r ? xcd * (q + 1) : r * (q + 1) + (xcd - r) * q) + off; }
        const int nig = WGM * nN, gid = wgid / nig, fm = gid * WGM, gsz = (nM - fm) < WGM ? (nM - fm) : WGM;
        u.pm = fm + ((wgid % nig) % gsz); u.pn = (wgid % nig) / gsz; return true;
    }
    __device__ __forceinline__ void a_ready(const Unit&) const {}
    __device__ __forceinline__ void done(const Unit&) const {}
};

struct EpiH {
    static constexpr bool PERM = true, AFTER_DRAIN = false;
    _Float16* O; int ldc;
    __device__ __forceinline__ void operator()(const f32x4 (&acc)[2][2][4][2], const Unit& u, int wr, int wc, int fr, int fq) const {
        const int row0 = u.pm * BM + wr * 64 + fr; const int col0 = u.pn * BM + wc * 32 + 8 * fq;
#pragma unroll
        for (int ai = 0; ai < 2; ++ai)
#pragma unroll
            for (int m = 0; m < 4; ++m) { _Float16* rowp = O + (size_t)(row0 + ai * HALF + m * 16) * ldc + col0;
#pragma unroll
                for (int bj = 0; bj < 2; ++bj) { const f32x4 v0 = acc[ai][bj][m][0], v1 = acc[ai][bj][m][1];
                    u32x4 w; w.x = pk2h(v0[0], v0[1]); w.y = pk2h(v0[2], v0[3]); w.z = pk2h(v1[0], v1[1]); w.w = pk2h(v1[2], v1[3]);
                    *(u32x4*)(rowp + bj * HALF) = w; } }
    }
};
struct EpiY {
    static constexpr bool PERM = false, AFTER_DRAIN = false;
    const float* base; float* out; float alpha;
    __device__ __forceinline__ void operator()(const f32x4 (&acc)[2][2][4][2], const Unit& u, int wr, int wc, int fr, int fq) const {
        const int col0 = u.pn * BM + wc * 32 + 4 * fq;
#pragma unroll
        for (int ai = 0; ai < 2; ++ai)
#pragma unroll
            for (int m = 0; m < 4; ++m) { const int r = u.pm * BM + ai * HALF + wr * 64 + m * 16 + fr; const size_t off = (size_t)r * 1024 + col0;
#pragma unroll
                for (int bj = 0; bj < 2; ++bj)
#pragma unroll
                    for (int n = 0; n < 2; ++n) { const f32x4 bs = *(const f32x4*)(base + off + bj * HALF + n * 16); *(f32x4*)(out + off + bj * HALF + n * 16) = acc[ai][bj][m][n] + bs * alpha; } }
    }
};
template <class Epi, class Sched, bool ALIGN_EPI = false, bool SP2 = false>
__device__ __forceinline__ void gemm_phase(PG8_LAS unsigned char* lds, const Gemm g, const Sched& S, const Epi& E) {
    int tid_ = threadIdx.x; asm volatile("" : "+v"(tid_));
    const int tid = tid_, wid = __builtin_amdgcn_readfirstlane(tid >> 6), lane = tid & 63, wr = wid >> 2, wc = wid & 3, fr = lane & 15, fq = lane >> 4;
    const int K = g.K, nt = K / BK;
    unsigned voffA[2], voffB[2];
#pragma unroll
    for (int i = 0; i < 2; ++i) { int R, C; stage_rc(tid * 16 + i * 8192, R, C); const int Rb = Epi::PERM ? ((R & ~31) + perm32(R & 31)) : R;
        voffA[i] = (unsigned)(R * K + C) * 2u; voffB[i] = (unsigned)(Rb * K + C) * 2u; }
    const size_t kstep = (size_t)(BK * 2);
    const size_t hstep = (size_t)HALF * K * 2;
    const size_t tstep = 2 * hstep;
    const unsigned ldsw = (unsigned)wid * 1024u;
    const int aoff = lds_byte(wr * 64 + fr, fq * 8), boff = lds_byte(wc * 32 + fr, fq * 8);
#define PG8_SA(b, h) (((b) * 2 + (h)) * HTB)
#define PG8_SB(b, h) ((4 + (b) * 2 + (h)) * HTB)
#define PG8_STAGE(bufoff, gbase, voff) do { _Pragma("unroll") for (int _i = 0; _i < 2; ++_i) \
        __builtin_amdgcn_global_load_lds((const unsigned*)((const char*)(gbase) + (voff)[_i]), (PG8_LAS unsigned*)(lds + (bufoff) + ldsw + _i * 8192), 16, 0, 0); } while (0)
#define PG8_LDA(dst, b, h) do { _Pragma("unroll") for (int m = 0; m < 4; ++m) _Pragma("unroll") for (int k = 0; k < 2; ++k) dst[m][k] = *(const PG8_LAS bf16x8*)(lds + PG8_SA(b, h) + aoff + m * 2048 + k * 1024); } while (0)
#define PG8_LDB(dst, b, h) do { _Pragma("unroll") for (int n = 0; n < 2; ++n) _Pragma("unroll") for (int k = 0; k < 2; ++k) dst[n][k] = *(const PG8_LAS bf16x8*)(lds + PG8_SB(b, h) + boff + n * 2048 + k * 1024); } while (0)
#define PG8_MMA(ai, bj, At, Bt) do { __builtin_amdgcn_s_setprio(1); _Pragma("unroll") for (int m = 0; m < 4; ++m) _Pragma("unroll") for (int n = 0; n < 2; ++n) _Pragma("unroll") for (int k = 0; k < 2; ++k) \
        acc[ai][bj][m][n] = __builtin_amdgcn_mfma_f32_16x16x32_f16(__builtin_bit_cast(h16x8, Bt[n][k]), __builtin_bit_cast(h16x8, At[m][k]), acc[ai][bj][m][n], 0, 0, 0); __builtin_amdgcn_s_setprio(0); } while (0)
#define PG8_WAIT_V(n) asm volatile("s_waitcnt vmcnt(" #n ")" ::: "memory")
#define PG8_WAIT_L(n) asm volatile("s_waitcnt lgkmcnt(" #n ")" ::: "memory")
#define PG8_BAR __builtin_amdgcn_s_barrier()
#define PG8_SCHED __builtin_amdgcn_sched_barrier(0)
    Unit cur, nxt; int ui = 0;
    if (!S.next(0, cur)) return;
    f32x4 acc[2][2][4][2];
#pragma unroll
    for (int a = 0; a < 2; ++a)
#pragma unroll
        for (int b = 0; b < 2; ++b)
#pragma unroll
            for (int m = 0; m < 4; ++m)
#pragma unroll
                for (int n = 0; n < 2; ++n) acc[a][b][m][n] = (f32x4){0.f, 0.f, 0.f, 0.f};
    bf16x8 At[4][2], B0[2][2], B1[2][2];
    const char* cA = (const char*)g.A + (size_t)cur.pm * tstep; const char* cB = (const char*)g.Bt + (size_t)cur.pn * tstep;
    S.a_ready(cur);
    if constexpr (SP2) {
        PG8_STAGE(PG8_SB(0, 0), cB, voffB); PG8_STAGE(PG8_SB(0, 1), cB + hstep, voffB); PG8_STAGE(PG8_SA(0, 0), cA, voffA); PG8_STAGE(PG8_SA(0, 1), cA + hstep, voffA);
        if (wr == 1) PG8_BAR;
        PG8_WAIT_V(2); PG8_BAR;
        PG8_STAGE(PG8_SB(1, 0), cB + kstep, voffB); PG8_STAGE(PG8_SA(1, 0), cA + kstep, voffA); PG8_STAGE(PG8_SB(1, 1), cB + hstep + kstep, voffB);
        PG8_WAIT_V(6); PG8_BAR;
    } else {
        PG8_STAGE(PG8_SB(0, 0), cB, voffB); PG8_STAGE(PG8_SA(0, 0), cA, voffA); PG8_STAGE(PG8_SB(0, 1), cB + hstep, voffB); PG8_STAGE(PG8_SA(0, 1), cA + hstep, voffA);
        if (wr == 1) PG8_BAR;
        PG8_WAIT_V(4); PG8_BAR;
        PG8_STAGE(PG8_SB(1, 0), cB + kstep, voffB); PG8_STAGE(PG8_SA(1, 0), cA + kstep, voffA); PG8_STAGE(PG8_SB(1, 1), cB + hstep + kstep, voffB);
        PG8_WAIT_V(6); PG8_BAR;
    }
    for (;;) {
        const bool has_next = S.next(ui + 1, nxt);
        const char* nA = has_next ? (const char*)g.A + (size_t)nxt.pm * tstep : cA; const char* nB = has_next ? (const char*)g.Bt + (size_t)nxt.pn * tstep : cB;
        for (int t = 0; t < nt; t += 2) {
            const bool last = (t == nt - 2);
            const char* a1 = cA + (size_t)(t + 1) * kstep;
            const char* a2 = last ? nA : cA + (size_t)(t + 2) * kstep; const char* b2 = last ? nB : cB + (size_t)(t + 2) * kstep;
            const char* a3 = a2 + kstep; const char* b3 = b2 + kstep;
            if (last && has_next) S.a_ready(nxt);
            if constexpr (SP2) {
            PG8_LDB(B0, 0, 0); PG8_LDB(B1, 0, 1); PG8_SCHED; PG8_LDA(At, 0, 0); PG8_STAGE(PG8_SA(1, 1), a1 + hstep, voffA);
            PG8_WAIT_V(8); PG8_WAIT_L(0); PG8_BAR; PG8_MMA(0, 0, At, B0); PG8_MMA(0, 1, At, B1); PG8_BAR; PG8_SCHED;
            PG8_LDA(At, 0, 1); PG8_STAGE(PG8_SB(0, 0), b2, voffB); PG8_STAGE(PG8_SB(0, 1), b2 + hstep, voffB); PG8_STAGE(PG8_SA(0, 0), a2, voffA);
            PG8_WAIT_V(8); PG8_WAIT_L(0); PG8_BAR; PG8_MMA(1, 0, At, B0); PG8_MMA(1, 1, At, B1); PG8_BAR; PG8_SCHED;
            PG8_LDB(B0, 1, 0); PG8_LDB(B1, 1, 1); PG8_SCHED; PG8_LDA(At, 1, 0); PG8_STAGE(PG8_SA(0, 1), a2 + hstep, voffA);
            PG8_WAIT_V(8); PG8_WAIT_L(0); PG8_BAR; PG8_MMA(0, 0, At, B0); PG8_MMA(0, 1, At, B1); PG8_BAR; PG8_SCHED;
            PG8_LDA(At, 1, 1); PG8_STAGE(PG8_SB(1, 0), b3, voffB); PG8_STAGE(PG8_SB(1, 1), b3 + hstep, voffB); PG8_STAGE(PG8_SA(1, 0), a3, voffA);
            PG8_WAIT_V(8); PG8_WAIT_L(0); PG8_BAR; PG8_MMA(1, 0, At, B0); PG8_MMA(1, 1, At, B1); PG8_BAR; PG8_SCHED;
            } else {
            PG8_LDB(B0, 0, 0); PG8_SCHED; PG8_LDA(At, 0, 0); PG8_STAGE(PG8_SA(1, 1), a1 + hstep, voffA);
            PG8_WAIT_L(8); PG8_BAR; PG8_WAIT_L(0); PG8_MMA(0, 0, At, B0); PG8_BAR; PG8_SCHED;
            PG8_LDB(B1, 0, 1); PG8_STAGE(PG8_SB(0, 0), b2, voffB);
            PG8_BAR; PG8_WAIT_L(0); PG8_MMA(0, 1, At, B1); PG8_BAR;
            PG8_LDA(At, 0, 1); PG8_STAGE(PG8_SA(0, 0), a2, voffA);
            PG8_BAR; PG8_WAIT_L(0); PG8_MMA(1, 0, At, B0); PG8_BAR; PG8_SCHED;
            PG8_STAGE(PG8_SB(0, 1), b2 + hstep, voffB);
            PG8_WAIT_V(6); PG8_BAR; PG8_MMA(1, 1, At, B1); PG8_BAR;
            PG8_LDB(B0, 1, 0); PG8_SCHED; PG8_LDA(At, 1, 0); PG8_STAGE(PG8_SA(0, 1), a2 + hstep, voffA);
            PG8_WAIT_L(8); PG8_BAR; PG8_WAIT_L(0); PG8_MMA(0, 0, At, B0); PG8_BAR; PG8_SCHED;
            PG8_LDB(B1, 1, 1); PG8_STAGE(PG8_SB(1, 0), b3, voffB);
            PG8_BAR; PG8_WAIT_L(0); PG8_MMA(0, 1, At, B1); PG8_BAR;
            PG8_LDA(At, 1, 1); PG8_STAGE(PG8_SA(1, 0), a3, voffA);
            PG8_BAR; PG8_WAIT_L(0); PG8_MMA(1, 0, At, B0); PG8_BAR; PG8_SCHED;
            PG8_STAGE(PG8_SB(1, 1), b3 + hstep, voffB);
            PG8_WAIT_V(6); PG8_BAR; PG8_MMA(1, 1, At, B1); PG8_BAR;
            }
        }
        if constexpr (ALIGN_EPI) { if (wr == 0) PG8_BAR; }
        if constexpr (!Epi::AFTER_DRAIN) { E(acc, cur, wr, wc, fr, fq); S.done(cur); }
        if (!has_next) break;
#pragma unroll
        for (int a = 0; a < 2; ++a)
#pragma unroll
            for (int b = 0; b < 2; ++b)
#pragma unroll
                for (int m = 0; m < 4; ++m)
#pragma unroll
                    for (int n = 0; n < 2; ++n) acc[a][b][m][n] = (f32x4){0.f, 0.f, 0.f, 0.f};
        cur = nxt; cA = nA; cB = nB; ++ui;
        if constexpr (ALIGN_EPI) { if (wr == 1) PG8_BAR; }
    }
    PG8_WAIT_V(0);
    if constexpr (!ALIGN_EPI) { if (wr == 0) PG8_BAR; }
    PG8_BAR;
    if constexpr (Epi::AFTER_DRAIN) { E.fused(acc, cur, wr, wc, fr, fq, lds, wid, lane); S.done(cur); }
#undef PG8_SA
#undef PG8_SB
#undef PG8_STAGE
#undef PG8_LDA
#undef PG8_LDB
#undef PG8_MMA
#undef PG8_WAIT_V
#undef PG8_WAIT_L
#undef PG8_BAR
#undef PG8_SCHED
}
}

#define PHASE_IDS() int tid = threadIdx.x; asm volatile("" : "+v"(tid)); const int lane = tid & 63, wave = __builtin_amdgcn_readfirstlane(tid >> 6); (void)lane; (void)wave; unsigned char* ws = p.ws; asm volatile("" : "+s"(ws))
typedef short v4i16_t __attribute__((ext_vector_type(4)));
__device__ __forceinline__ h16x4 tr_read4(const LAS unsigned char* p) { return __builtin_bit_cast(h16x4, __builtin_amdgcn_ds_read_tr16_b64_v4i16((LAS v4i16_t*)p)); }
__device__ __forceinline__ h16x8 vt_frag(const LAS unsigned char* vimg, int half_bytes, int et, int st, int lane) {
    const int hi = lane >> 5, blk = (lane >> 4) & 1, q = (lane & 15) >> 2, pp = lane & 3;
    const LAS unsigned char* a = vimg + et * half_bytes + (16 * st + 4 * hi + q) * 64 + (16 * blk + 4 * pp) * 2;
    const h16x4 lo = tr_read4(a), hh = tr_read4(a + 8 * 64);
    return (h16x8){lo[0], lo[1], lo[2], lo[3], hh[0], hh[1], hh[2], hh[3]};
}
__device__ __forceinline__ float silu_f(float z) { return z / (1.f + __expf(-z)); }

constexpr int SBL_K = 0, SBL_KB = 4608, SBL_V = 9216, SBL_VB = 4096, SBL_FLAG = 17408;
__device__ __forceinline__ void sb_unit(const Params& p, int unit, LAS unsigned char* lds) {
    PHASE_IDS();
    const h16* H = (const h16*)(ws + WS_H); h16* MIX = (h16*)(ws + WS_MIX);
    const int qb = unit & 15, bh = unit >> 4, hh = bh & 3, b = bh >> 2;
    const int r32 = lane & 31, hi = lane >> 5;
    const int t0 = 256 * qb, tb = t0 + 32 * wave, Ttop = 8 * qb + 7, Tdiag = 8 * qb + wave;
    LAS int* flags = (LAS int*)(lds + SBL_FLAG);
    const size_t qrow = (size_t)(b * SEQ + tb + r32) * NH;
    h16x8 qf[4];
#pragma unroll
    for (int ks = 0; ks < 4; ++ks) { qf[ks] = *(const h16x8*)(H + qrow + C_SQ + hh * 64 + 16 * ks + 8 * hi); qf[ks] = qf[ks] * (h16)0.125f; }
    f32x16 o0 = {}, o1 = {};
    float R = 1.f; bool done = false;
    const int li = tid & 255, lrow = li >> 3, lc = li & 7; const bool isV = tid >= 256;
    const h16* gsrc = H + (size_t)(b * SEQ + lrow) * NH + (isV ? C_SV : C_SK) + hh * 64 + 8 * lc;
    const int ldst = isV ? SBL_V + (lc >> 2) * 2048 + lrow * 64 + (lc & 3) * 16 : SBL_K + lrow * 144 + lc * 16;
    const int lbuf = isV ? SBL_VB : SBL_KB;
    { const u32x4 v = *(const u32x4*)(gsrc + (size_t)Ttop * 32 * NH); *(LAS u32x4*)(lds + ldst) = v; }
    __syncthreads();
    int buf = 0, it = 0;
    for (int T = Ttop; T >= 0; --T, ++it) {
        u32x4 nxt = {0u, 0u, 0u, 0u};
        if (T > 0) nxt = *(const u32x4*)(gsrc + (size_t)(T - 1) * 32 * NH);
        if (T <= Tdiag && !done) {
            const LAS unsigned char* kimg = lds + SBL_K + buf * SBL_KB; const LAS unsigned char* vimg = lds + SBL_V + buf * SBL_VB;
            f32x16 z = {};
#pragma unroll
            for (int ks = 0; ks < 4; ++ks) { const h16x8 kf = *(const LAS h16x8*)(kimg + r32 * 144 + (16 * ks + 8 * hi) * 2); z = mfma32(kf, qf[ks], z); }
            float om[16], be[16];
            const bool diag = (T == Tdiag);
#pragma unroll
            for (int r = 0; r < 16; ++r) {
                const float u = __expf(fminf(z[r], 80.f)), rr = __builtin_amdgcn_rcpf(1.f + u);
                const bool valid = !diag || (crow(r, hi) < r32);
                om[r] = valid ? rr : 1.f; be[r] = valid ? u * rr : 0.f;
            }
            float G[4], Gp[4];
#pragma unroll
            for (int g = 0; g < 4; ++g) { G[g] = (om[4 * g] * om[4 * g + 1]) * (om[4 * g + 2] * om[4 * g + 3]); Gp[g] = xhalf(G[g], hi); }
            float E[4]; float run = R;
#pragma unroll
            for (int g = 3; g >= 0; --g) { E[g] = hi ? run : run * Gp[g]; run = run * (G[g] * Gp[g]); }
            h16x8 pf[2];
#pragma unroll
            for (int g = 0; g < 4; ++g) {
                const float w3 = E[g], w2 = w3 * om[4 * g + 3], w1 = w2 * om[4 * g + 2], w0 = w1 * om[4 * g + 1];
                pf[g >> 1][4 * (g & 1) + 0] = (h16)(be[4 * g + 0] * w0); pf[g >> 1][4 * (g & 1) + 1] = (h16)(be[4 * g + 1] * w1);
                pf[g >> 1][4 * (g & 1) + 2] = (h16)(be[4 * g + 2] * w2); pf[g >> 1][4 * (g & 1) + 3] = (h16)(be[4 * g + 3] * w3);
            }
            R = run;
#pragma unroll
            for (int st = 0; st < 2; ++st) {
                o0 = mfma32(vt_frag(vimg, 2048, 0, st, lane), pf[st], o0);
                o1 = mfma32(vt_frag(vimg, 2048, 1, st, lane), pf[st], o1);
            }
            done = (__builtin_amdgcn_ballot_w64(R >= 1e-37f) == 0ull);
        }
        if (T > 0) *(LAS u32x4*)(lds + ldst + (buf ^ 1) * lbuf) = nxt;
        if (lane == 0) flags[(it & 1) * 8 + wave] = done ? 1 : 0;
        __syncthreads();
        int alld = 1;
#pragma unroll
        for (int w = 0; w < 8; ++w) alld &= flags[(it & 1) * 8 + w];
        if (alld) break;
        buf ^= 1;
    }
#pragma unroll
    for (int et = 0; et < 2; ++et)
#pragma unroll
        for (int g = 0; g < 4; ++g) {
            const int e = 32 * et + 8 * g + 4 * hi;
            const h16x4 zz = *(const h16x4*)(H + qrow + C_SZ + hh * 64 + e);
            h16x4 ov;
#pragma unroll
            for (int i = 0; i < 4; ++i) { const float ov_f = (et ? o1[4 * g + i] : o0[4 * g + i]); ov[i] = (h16)(ov_f * silu_f((float)zz[i])); }
            *(h16x4*)(MIX + (size_t)(b * SEQ + tb + r32) * DM + 384 + hh * 64 + e) = ov;
        }
    __syncthreads();
}

constexpr int NSL_K = 0, NSL_KB = 4608, NSL_V = 9216, NSL_VB = 4096, NSL_BT = 17408, NSL_IMP = 19456, NSL_END = NSL_IMP + 8 * 16 * 65 * 4;
constexpr float NSA_NEG = -1e30f;
struct NsaW { h16x8 qf[3][2]; f32x4 o[3][4]; float m[3], l[3]; };
__device__ __forceinline__ float max4(float v, int hi) { v = fmaxf(v, __shfl_xor(v, 16)); return fmaxf(v, xhalf(v, hi)); }
__device__ __forceinline__ float sum4(float v, int hi) { v += __shfl_xor(v, 16); return v + xhalf(v, hi); }

template <int MODE>
__device__ __forceinline__ void nsa_pass(NsaW& W, const h16* kbase, const h16* vbase, int pitch, int kt_lo, int kt_hi, int tw, int t, unsigned long long sel,
                                         LAS unsigned char* lds, const LAS float* BT, LAS float* impw, int tid, int lane, int wave) {
    const int fr = lane & 15, kq = lane >> 4, hi = lane >> 5;
    const int li = tid & 255, lrow = li >> 3, lc = li & 7; const bool isV = tid >= 256;
    const h16* gsrc = (isV ? vbase : kbase) + (size_t)lrow * pitch + 8 * lc;
    const int ldst = isV ? NSL_V + (lc >> 2) * 2048 + lrow * 64 + (lc & 3) * 16 : NSL_K + lrow * 144 + lc * 16;
    const int lbuf = isV ? NSL_VB : NSL_KB;
    { const u32x4 v = *(const u32x4*)(gsrc + (size_t)kt_lo * 32 * pitch); *(LAS u32x4*)(lds + ldst) = v; }
    __syncthreads();
    int buf = 0; float prev_carry = 0.f;
    for (int kt = kt_lo; kt <= kt_hi; ++kt) {
        u32x4 nxt = {0u, 0u, 0u, 0u};
        if (kt < kt_hi) nxt = *(const u32x4*)(gsrc + (size_t)(kt + 1) * 32 * pitch);
        bool act;
        if (MODE <= 1) act = (512 * kt + 16 <= tw);
        else if (MODE == 2) { const int j = kt >> 1; act = (32 * kt <= tw + 15) && (__builtin_amdgcn_ballot_w64((sel >> j) & 1ull) != 0ull); }
        else act = !(32 * kt + 31 < tw - 511 || 32 * kt > tw + 15);
        if (act) {
            const LAS unsigned char* kimg = lds + NSL_K + buf * NSL_KB; const LAS unsigned char* vimg = lds + NSL_V + buf * NSL_VB;
            h16x8 kf[2][2];
#pragma unroll
            for (int sub = 0; sub < 2; ++sub)
#pragma unroll
                for (int ks = 0; ks < 2; ++ks) kf[sub][ks] = *(const LAS h16x8*)(kimg + (16 * sub + fr) * 144 + (32 * ks + 8 * kq) * 2);
            h16x8 vf[4];
            if (MODE != 0) {
#pragma unroll
                for (int et = 0; et < 4; ++et) {
                    const LAS unsigned char* a = vimg + (et >> 1) * 2048 + (4 * kq + ((lane & 15) >> 2)) * 64 + (16 * (et & 1) + 4 * (lane & 3)) * 2;
                    const h16x4 lo = tr_read4(a), hh4 = tr_read4(a + 16 * 64);
                    vf[et] = (h16x8){lo[0], lo[1], lo[2], lo[3], hh4[0], hh4[1], hh4[2], hh4[3]};
                }
            }
            __builtin_amdgcn_sched_barrier(0);
            const bool selbit = (MODE == 2) ? (((sel >> (kt >> 1)) & 1ull) != 0ull) : true;
            float Lloc[2] = {0.f, 0.f}, Llast[2] = {0.f, 0.f};
#pragma unroll
            for (int hh = 0; hh < 3; ++hh) {
                f32x4 s[2];
#pragma unroll
                for (int sub = 0; sub < 2; ++sub) { s[sub] = (f32x4){0.f, 0.f, 0.f, 0.f}; s[sub] = mfma16(kf[sub][0], W.qf[hh][0], s[sub]); s[sub] = mfma16(kf[sub][1], W.qf[hh][1], s[sub]); }
                float sc[2][4]; float tmax = NSA_NEG;
#pragma unroll
                for (int sub = 0; sub < 2; ++sub)
#pragma unroll
                    for (int r = 0; r < 4; ++r) {
                        const int key = 32 * kt + 16 * sub + 4 * kq + r;
                        const int rel = (MODE <= 1) ? t - (16 * key + 31) : t - key;
                        bool v = rel >= 0;
                        if (MODE == 2) v = v && selbit;
                        if (MODE == 3) v = v && rel < 512;
                        const int ri = rel < 0 ? 0 : (rel > 127 ? 127 : rel);
                        const float x = s[sub][r] + BT[hh * 128 + ri];
                        sc[sub][r] = v ? x : NSA_NEG; tmax = fmaxf(tmax, sc[sub][r]);
                    }
                if (MODE == 0) {
                    const float mn = fmaxf(W.m[hh], tmax); float ps = 0.f;
#pragma unroll
                    for (int sub = 0; sub < 2; ++sub)
#pragma unroll
                        for (int r = 0; r < 4; ++r) ps += (sc[sub][r] > -1e29f) ? __expf(sc[sub][r] - mn) : 0.f;
                    W.l[hh] = W.l[hh] * __expf(W.m[hh] - mn) + ps; W.m[hh] = mn;
                } else {
                    float pv[2][4];
                    if (MODE == 1) {
#pragma unroll
                        for (int sub = 0; sub < 2; ++sub)
#pragma unroll
                            for (int r = 0; r < 4; ++r) { pv[sub][r] = (sc[sub][r] > -1e29f) ? __expf(sc[sub][r] - W.m[hh]) * W.l[hh] : 0.f; Lloc[sub] += pv[sub][r]; }
                        Llast[0] += pv[0][3]; Llast[1] += pv[1][3];
                    } else {
                        const float mt = max4(tmax, hi), mn = fmaxf(W.m[hh], mt), alpha = __expf(W.m[hh] - mn); float ps = 0.f;
#pragma unroll
                        for (int sub = 0; sub < 2; ++sub)
#pragma unroll
                            for (int r = 0; r < 4; ++r) { pv[sub][r] = (sc[sub][r] > -1e29f) ? __expf(sc[sub][r] - mn) : 0.f; ps += pv[sub][r]; }
                        W.l[hh] = W.l[hh] * alpha + ps; W.m[hh] = mn;
#pragma unroll
                        for (int et = 0; et < 4; ++et) W.o[hh][et] = W.o[hh][et] * alpha;
                    }
                    const h16x8 pf = {(h16)pv[0][0], (h16)pv[0][1], (h16)pv[0][2], (h16)pv[0][3], (h16)pv[1][0], (h16)pv[1][1], (h16)pv[1][2], (h16)pv[1][3]};
#pragma unroll
                    for (int et = 0; et < 4; ++et) W.o[hh][et] = mfma16(vf[et], pf, W.o[hh][et]);
                }
                __builtin_amdgcn_sched_barrier(0);
            }
            if (MODE == 1) {
                const float up0 = __shfl(Llast[0], (lane - 16) & 63), up1 = __shfl(Llast[1], (lane - 16) & 63);
                const float own0 = Lloc[0] + (kq ? up0 : prev_carry), own1 = Lloc[1] + (kq ? up1 : up0);
                prev_carry = up1;
                impw[fr * 65 + 8 * kt + kq] = own0; impw[fr * 65 + 8 * kt + 4 + kq] = own1;
            }
        }
        if (kt < kt_hi) *(LAS u32x4*)(lds + ldst + (buf ^ 1) * lbuf) = nxt;
        __syncthreads();
        buf ^= 1;
    }
}

__device__ __forceinline__ void nsa_unit(const Params& p, int unit, LAS unsigned char* lds) {
    PHASE_IDS();
    const h16* H = (const h16*)(ws + WS_H); h16* MIX = (h16*)(ws + WS_MIX);
    const int ub = ((unit >> 8) & 1) ? (unit & 31) : 31 - (unit & 31), bg = unit >> 5, g = bg & 1, b = bg >> 1;
    const int fr = lane & 15, kq = lane >> 4, hi = lane >> 5;
    const int t0 = 128 * ub, tw = t0 + 16 * wave, t = tw + fr, cur = tw >> 6;
    LAS float* BT = (LAS float*)(lds + NSL_BT); LAS float* impw = (LAS float*)(lds + NSL_IMP) + wave * (16 * 65);
    if (tid < 384) { const int hh = tid >> 7, d = tid & 127; int bk = d;
        if (d >= 16) bk = 16 + (d >= 19) + (d >= 21) + (d >= 24) + (d >= 27) + (d >= 31) + (d >= 35) + (d >= 40) + (d >= 46) + (d >= 52) + (d >= 59) + (d >= 67) + (d >= 77) + (d >= 87) + (d >= 99) + (d >= 113);
        BT[tid] = p.in[12][bk * 6 + g * 3 + hh]; }
    for (int i = lane; i < 16 * 65; i += 64) impw[i] = 0.f;
    const size_t hrow = (size_t)(b * SEQ + t) * NH;
    NsaW W;
#pragma unroll
    for (int hh = 0; hh < 3; ++hh)
#pragma unroll
        for (int ks = 0; ks < 2; ++ks) { W.qf[hh][ks] = *(const h16x8*)(H + hrow + C_NQ + (g * 3 + hh) * 64 + 32 * ks + 8 * kq); W.qf[hh][ks] = W.qf[hh][ks] * (h16)0.125f; }
#define NSA_GATE(hh, i) (1.f / (1.f + __expf(-(float)H[hrow + C_G + (g * 3 + (hh)) * 3 + (i)])))
#define NSA_ACC(hh, et, scale, FIRST, LAST) do { const int e_ = 16 * (et) + 4 * kq, hc_ = (g * 3 + (hh)) * 64 + e_; h16* dst_ = MIX + (size_t)(b * SEQ + t) * DM + hc_; \
        f32x4 a_ = W.o[hh][et] * (scale); \
        if (!(FIRST)) { const h16x4 d_ = *(const h16x4*)dst_; a_ = a_ + (f32x4){(float)d_[0], (float)d_[1], (float)d_[2], (float)d_[3]}; } \
        if (LAST) { const h16x4 zz_ = *(const h16x4*)(H + hrow + C_NZ + hc_); a_ = a_ * (f32x4){silu_f((float)zz_[0]), silu_f((float)zz_[1]), silu_f((float)zz_[2]), silu_f((float)zz_[3])}; } \
        *(h16x4*)dst_ = (h16x4){(h16)a_[0], (h16)a_[1], (h16)a_[2], (h16)a_[3]}; } while (0)
    __syncthreads();
    const h16* KC = (const h16*)(ws + WS_KC) + (size_t)bg * 256 * 64; const h16* VC = (const h16*)(ws + WS_VCT) + (size_t)bg * 256 * 64;
    const int ct_hi = (t0 + 127 - 16 < 0) ? 0 : (t0 + 127 - 16) / 512;
#pragma unroll
    for (int hh = 0; hh < 3; ++hh) { W.m[hh] = NSA_NEG; W.l[hh] = 0.f; }
    nsa_pass<0>(W, KC, VC, 64, 0, ct_hi, tw, t, 0ull, lds, BT, impw, tid, lane, wave);
#pragma unroll
    for (int hh = 0; hh < 3; ++hh) { const float mr = max4(W.m[hh], hi); const float lr = sum4(W.l[hh] * __expf(W.m[hh] - mr), hi); W.m[hh] = mr; W.l[hh] = lr > 0.f ? 1.f / lr : 0.f;
#pragma unroll
        for (int et = 0; et < 4; ++et) W.o[hh][et] = (f32x4){0.f, 0.f, 0.f, 0.f}; }
    nsa_pass<1>(W, KC, VC, 64, 0, ct_hi, tw, t, 0ull, lds, BT, impw, tid, lane, wave);
#pragma unroll
    for (int hh = 0; hh < 3; ++hh) { const float sc = NSA_GATE(hh, 0);
#pragma unroll
        for (int et = 0; et < 4; ++et) NSA_ACC(hh, et, sc, true, false); }
    asm volatile("s_waitcnt lgkmcnt(0)" ::: "memory");
    unsigned long long sel;
    if (cur <= 15) sel = (2ull << cur) - 1ull;
    else {
        float v[16];
#pragma unroll
        for (int i = 0; i < 16; ++i) { const int j = 4 * i + kq; v[i] = (j >= 1 && j <= cur - 2) ? impw[fr * 65 + j] : -1.f; }
        sel = 1ull | (3ull << (cur - 1));
        for (int round = 0; round < 13; ++round) {
            float bv = v[0]; int bj = kq;
#pragma unroll
            for (int i = 1; i < 16; ++i) if (v[i] > bv) { bv = v[i]; bj = 4 * i + kq; }
            { const float ov = __shfl_xor(bv, 16); const int oj = __shfl_xor(bj, 16); if (ov > bv || (ov == bv && oj < bj)) { bv = ov; bj = oj; } }
            { const float ov = __shfl_xor(bv, 32); const int oj = __shfl_xor(bj, 32); if (ov > bv || (ov == bv && oj < bj)) { bv = ov; bj = oj; } }
            sel |= 1ull << bj;
#pragma unroll
            for (int i = 0; i < 16; ++i) v[i] = (4 * i + kq == bj) ? -1.f : v[i];
        }
    }
    const h16* Hb = H + (size_t)b * SEQ * NH;
#pragma unroll
    for (int hh = 0; hh < 3; ++hh) { W.m[hh] = NSA_NEG; W.l[hh] = 0.f;
#pragma unroll
        for (int et = 0; et < 4; ++et) W.o[hh][et] = (f32x4){0.f, 0.f, 0.f, 0.f}; }
    nsa_pass<2>(W, Hb + C_KS + g * 64, Hb + C_VS + g * 64, NH, 0, (t0 + 127) >> 5, tw, t, sel, lds, BT, impw, tid, lane, wave);
#pragma unroll
    for (int hh = 0; hh < 3; ++hh) { const float lr = sum4(W.l[hh], hi); const float sc = lr > 0.f ? NSA_GATE(hh, 1) / lr : 0.f;
#pragma unroll
        for (int et = 0; et < 4; ++et) NSA_ACC(hh, et, sc, false, false); }
#pragma unroll
    for (int hh = 0; hh < 3; ++hh) { W.m[hh] = NSA_NEG; W.l[hh] = 0.f;
#pragma unroll
        for (int et = 0; et < 4; ++et) W.o[hh][et] = (f32x4){0.f, 0.f, 0.f, 0.f}; }
    nsa_pass<3>(W, Hb + C_KW + g * 64, Hb + C_VW + g * 64, NH, (t0 - 511 < 0) ? 0 : (t0 - 511) >> 5, (t0 + 127) >> 5, tw, t, 0ull, lds, BT, impw, tid, lane, wave);
#pragma unroll
    for (int hh = 0; hh < 3; ++hh) { const float lr = sum4(W.l[hh], hi); const float sc = lr > 0.f ? NSA_GATE(hh, 2) / lr : 0.f;
#pragma unroll
        for (int et = 0; et < 4; ++et) NSA_ACC(hh, et, sc, false, true); }
    __syncthreads();
}

#define LDS_WAIT() asm volatile("s_waitcnt lgkmcnt(0)" ::: "memory")
__device__ __forceinline__ void tr_item(const float* W, int ldw, int srccol0, h16* WT, int K, int dstrow0, int k0, LAS float* scr, int lane) {
#pragma unroll 8
    for (int i = 0; i < 32; ++i) { const int kk = 2 * i + (lane >> 5); scr[kk * 33 + (lane & 31)] = srccol0 >= 0 ? W[(size_t)(k0 + kk) * ldw + srccol0 + (lane & 31)] : 0.f; }
    LDS_WAIT(); asm volatile("" ::: "memory");
    const int c = lane & 7;
#pragma unroll
    for (int j = 0; j < 4; ++j) { const int n = (lane >> 3) + 8 * j; const LAS float* s = scr + (8 * c) * 33 + n;
        u32x4 o; o.x = pk2h(s[0 * 33], s[1 * 33]); o.y = pk2h(s[2 * 33], s[3 * 33]); o.z = pk2h(s[4 * 33], s[5 * 33]); o.w = pk2h(s[6 * 33], s[7 * 33]);
        *(u32x4*)(WT + (size_t)(dstrow0 + n) * K + k0 + 8 * c) = o; }
    LDS_WAIT(); asm volatile("" ::: "memory");
}

__device__ __forceinline__ void prologue(const Params& p, LAS unsigned char* lds) {
    PHASE_IDS();
    LAS float* scr = (LAS float*)(lds + wave * 16384);
    const int gw = blockIdx.x * 8 + wave, NGW = gridDim.x * 8;
    constexpr int I_IN = 16 * (NH / 32), I_OUT = 16 * 32, I_C1 = 32 * 4, I_C2 = 2 * 2;
    constexpr int N_IN = 2 * I_IN, N_OUT = 2 * I_OUT, N_C1 = 4 * I_C1, N_C2 = 4 * I_C2, N_PB = 128;
    constexpr int NITEMS = N_IN + N_OUT + N_C1 + N_C2 + N_PB;
    for (int it = gw; it < NITEMS; it += NGW) {
        int r = it;
        if (r < N_IN) { const int l = r / I_IN, q = r % I_IN, kb = q / (NH / 32), nb = q % (NH / 32), n0 = 32 * nb;
            const int src = n0 < 1152 ? n0 : (n0 < 4096 ? n0 + 18 : (n0 == 4096 ? 1152 : -1));
            tr_item(p.in[1] + (size_t)l * 1024 * DIN, DIN, src, (h16*)(ws + WS_WINT) + (size_t)l * NH * 1024, 1024, n0, 64 * kb, scr, lane); continue; }
        r -= N_IN;
        if (r < N_OUT) { const int l = r / I_OUT, q = r % I_OUT, kb = q / 32, nb = q % 32;
            tr_item(p.in[9] + (size_t)l * 1024 * 1024, 1024, 32 * nb, (h16*)(ws + WS_WOUTT) + (size_t)l * 1024 * 1024, 1024, 32 * nb, 64 * kb, scr, lane); continue; }
        r -= N_OUT;
        if (r < N_C1) { const int lk = r / I_C1, l = lk >> 1, kv = lk & 1, q = r % I_C1, kb = q / 4, nb = q % 4;
            tr_item((kv ? p.in[5] : p.in[3]) + (size_t)l * 2048 * 128, 128, 32 * nb, (h16*)(ws + WS_WC1T) + (size_t)lk * 128 * 2048, 2048, 32 * nb, 64 * kb, scr, lane); continue; }
        r -= N_C1;
        if (r < N_C2) { const int lk = r / I_C2, l = lk >> 1, kv = lk & 1, q = r % I_C2, kb = q / 2, nb = q % 2;
            tr_item((kv ? p.in[6] : p.in[4]) + (size_t)l * 128 * 64, 64, 32 * nb, (h16*)(ws + WS_WC2T) + (size_t)lk * 64 * 128, 128, 32 * nb, 64 * kb, scr, lane); continue; }
        r -= N_C2;
        {
            const int lk = r >> 5, l = lk >> 1, kv = lk & 1, c = r & 31;
            const float* w1 = (kv ? p.in[5] : p.in[3]) + (size_t)l * 2048 * 128; const float* pos = p.in[2] + (size_t)l * 2048;
            float a0 = 0.f, a1 = 0.f;
#pragma unroll 8
            for (int ii = 0; ii < 64; ++ii) { const int i = c * 64 + ii; const float pv = pos[i]; a0 += pv * w1[(size_t)i * 128 + lane]; a1 += pv * w1[(size_t)i * 128 + 64 + lane]; }
            float* o = (float*)(ws + WS_PBP) + ((size_t)lk * 32 + c) * 128; o[lane] = a0; o[64 + lane] = a1;
        }
    }
    const float* x = p.in[0]; h16* xh = (h16*)(ws + WS_XH);
    const size_t nvec = (size_t)MTOK * DM / 8;
    for (size_t i = (size_t)blockIdx.x * 512 + tid; i < nvec; i += (size_t)gridDim.x * 512) {
        const f32x4 a = *(const f32x4*)(x + i * 8), b = *(const f32x4*)(x + i * 8 + 4);
        u32x4 o; o.x = pk2h(a[0], a[1]); o.y = pk2h(a[2], a[3]); o.z = pk2h(b[0], b[1]); o.w = pk2h(b[2], b[3]);
        *(u32x4*)(xh + i * 8) = o;
    }
}

__device__ __forceinline__ void ln_phase(const Params& p, int layer) {
    PHASE_IDS();
    const float* Y = (const float*)(ws + WS_H); const float* g = p.in[10] + (size_t)layer * DM; const float* bb = p.in[11] + (size_t)layer * DM; float* xout = p.out; h16* xh = (h16*)(ws + WS_XH);
    const int gw = blockIdx.x * 8 + wave, NGW = gridDim.x * 8;
    f32x4 gv[4], bv[4];
#pragma unroll
    for (int j = 0; j < 4; ++j) { gv[j] = *((const f32x4*)g + lane + 64 * j); bv[j] = *((const f32x4*)bb + lane + 64 * j); }
    for (int m = gw; m < MTOK; m += NGW) {
        const f32x4* yr = (const f32x4*)(Y + (size_t)m * DM) + lane;
        f32x4 v[4]; float s = 0.f;
#pragma unroll
        for (int j = 0; j < 4; ++j) { v[j] = yr[64 * j]; s += (v[j][0] + v[j][1]) + (v[j][2] + v[j][3]); }
        const float mean = wave_sum(s) * (1.f / DM); float s2 = 0.f;
#pragma unroll
        for (int j = 0; j < 4; ++j) { v[j] = v[j] - mean; s2 += (v[j][0] * v[j][0] + v[j][1] * v[j][1]) + (v[j][2] * v[j][2] + v[j][3] * v[j][3]); }
        const float rstd = 1.f / sqrtf(wave_sum(s2) * (1.f / DM) + 1e-5f);
        f32x4* orow = (f32x4*)(xout + (size_t)m * DM) + lane; u32x2* hrow = (u32x2*)(xh + (size_t)m * DM) + lane;
#pragma unroll
        for (int j = 0; j < 4; ++j) { const f32x4 o = v[j] * rstd * gv[j] + bv[j]; orow[64 * j] = o; u32x2 w; w.x = pk2h(o[0], o[1]); w.y = pk2h(o[2], o[3]); hrow[64 * j] = w; }
    }
}

__device__ __forceinline__ float gelu_tanh(float x) {
    const float y = 0.7978845608028654f * (x + 0.044715f * x * x * x);
    const float t = 1.f - 2.f / (1.f + __expf(2.f * y));
    return 0.5f * x * (1.f + t);
}
__device__ __forceinline__ void compress_unit(const Params& p, int layer, int cu, LAS unsigned char* lds) {
    PHASE_IDS();
    const int nt = cu & 7, kv = (cu >> 3) & 1, g = (cu >> 4) & 1, b = cu >> 5, lk = layer * 2 + kv;
    const h16* H = (const h16*)(ws + WS_H);
    const h16* W1T = (const h16*)(ws + WS_WC1T) + (size_t)lk * 128 * 2048;
    const h16* W2T = (const h16*)(ws + WS_WC2T) + (size_t)lk * 64 * 128;
    const float* PBP = (const float*)(ws + WS_PBP) + (size_t)lk * 32 * 128;
    LAS h16* hid = (LAS h16*)lds;
    const int fr = lane & 15, kq = lane >> 4;
    const int colbase = (kv ? C_VC : C_KC) + g * 64;
    const int j0 = 16 * wave;
    f32x4 acc[2] = {{0.f, 0.f, 0.f, 0.f}, {0.f, 0.f, 0.f, 0.f}};
    const h16* bptr = W1T + (size_t)(j0 + fr) * 2048 + 8 * kq;
    const int n_a0 = 32 * nt + fr, n_a1 = n_a0 + 16;
#pragma unroll 4
    for (int ks = 0; ks < 64; ++ks) {
        const int pp = ks >> 1, dd = 32 * (ks & 1) + 8 * kq;
        int tok0 = 16 * n_a0 + pp; tok0 = tok0 > SEQ - 1 ? SEQ - 1 : tok0;
        int tok1 = 16 * n_a1 + pp; tok1 = tok1 > SEQ - 1 ? SEQ - 1 : tok1;
        const h16x8 a0 = *(const h16x8*)(H + (size_t)(b * SEQ + tok0) * NH + colbase + dd);
        const h16x8 a1 = *(const h16x8*)(H + (size_t)(b * SEQ + tok1) * NH + colbase + dd);
        const h16x8 bf = *(const h16x8*)(bptr + 32 * ks);
        acc[0] = mfma16(a0, bf, acc[0]); acc[1] = mfma16(a1, bf, acc[1]);
    }
    float bias = 0.f;
#pragma unroll 8
    for (int c = 0; c < 32; ++c) bias += PBP[c * 128 + j0 + fr];
#pragma unroll
    for (int rt = 0; rt < 2; ++rt)
#pragma unroll
        for (int r = 0; r < 4; ++r) hid[(16 * rt + 4 * kq + r) * 136 + j0 + fr] = (h16)gelu_tanh(acc[rt][r] + bias);
    __syncthreads();
    {
        const int rt = wave >> 2, dt = wave & 3;
        f32x4 o = {0.f, 0.f, 0.f, 0.f};
#pragma unroll
        for (int ks = 0; ks < 4; ++ks) {
            const h16x8 a = *(const LAS h16x8*)(hid + (16 * rt + fr) * 136 + 32 * ks + 8 * kq);
            const h16x8 bf = *(const h16x8*)(W2T + (size_t)(16 * dt + fr) * 128 + 32 * ks + 8 * kq);
            o = mfma16(a, bf, o);
        }
        const int d = 16 * dt + fr, n0 = 32 * nt + 16 * rt + 4 * kq;
        if (kv == 0) { h16* KC = (h16*)(ws + WS_KC) + (size_t)(b * 2 + g) * 256 * 64;
#pragma unroll
            for (int r = 0; r < 4; ++r) KC[(size_t)(n0 + r) * 64 + d] = (h16)o[r]; }
        else { h16* VC = (h16*)(ws + WS_VCT) + (size_t)(b * 2 + g) * 256 * 64;
#pragma unroll
            for (int r = 0; r < 4; ++r) VC[(size_t)(n0 + r) * 64 + d] = (h16)o[r]; }
    }
    __syncthreads();
}

constexpr int HGL_QS = 0, HGL_KS = 17408, HGL_BS = 34816, HGL_QT = 52224, HGL_VT = 61440, HGL_ST = 70656, HGL_AT = 79872, HGL_OS = 89088, HGL_TOT = 105728;
__device__ __forceinline__ void hg_prep(const h16* H, int r0, int hd, float lbv, int d, int seg, LAS float* tot, float (&bv)[8], float (&kv)[8], float& blast) {
    float cs = 0.f; const float lbf = fmaxf(lbv, 1e-30f), oml = 1.f - lbv;
#pragma unroll
    for (int i = 0; i < 8; ++i) {
        const float f = (float)H[(size_t)(r0 + 8 * seg + i) * NH + C_HF + hd * 64 + d];
        const float e = __expf(-fabsf(f)), r = 1.f / (1.f + e);
        const float sig = f >= 0.f ? r : e * r, sigm = f >= 0.f ? e * r : r;
        cs += __logf(lbf + oml * sig); bv[i] = cs; kv[i] = oml * sigm;
    }
    tot[seg * 64 + d] = cs;
    __syncthreads();
    float off = 0.f, all = 0.f;
#pragma unroll
    for (int s = 0; s < 8; ++s) { const float v = tot[s * 64 + d]; all += v; off += s < seg ? v : 0.f; }
#pragma unroll
    for (int i = 0; i < 8; ++i) bv[i] += off;
    blast = all;
}
__device__ __forceinline__ float hg_lb(const Params& p, int layer, int idx) {
    if (layer == 0) return 0.f;
    const float a0 = p.in[7][idx], a1 = p.in[7][384 + idx];
    return 1.f / (1.f + __expf(a0 - a1));
}
__device__ __forceinline__ void hg_state_unit(const Params& p, int layer, int u, LAS unsigned char* lds) {
    PHASE_IDS();
    const h16* H = (const h16*)(ws + WS_H);
    float* HGU = (float*)(ws + WS_HGU); float* HGD = (float*)(ws + WS_HGD);
    const int c = u & 63, bh = u >> 6, hd = bh % 6, b = bh / 6, r0 = b * SEQ + 64 * c;
    const int d = tid & 63, seg = tid >> 6;
    LAS h16* KT = (LAS h16*)(lds + HGL_QT); LAS h16* VT = (LAS h16*)(lds + HGL_VT); LAS float* tot = (LAS float*)(lds + HGL_TOT);
    float bv[8], kv[8], blast;
    hg_prep(H, r0, hd, hg_lb(p, layer, hd * 64 + d), d, seg, tot, bv, kv, blast);
    h16x8 kt, vt;
#pragma unroll
    for (int i = 0; i < 8; ++i) { kt[i] = (h16)(kv[i] * __expf(blast - bv[i])); vt[i] = H[(size_t)(r0 + 8 * seg + i) * NH + C_HI + hd * 64 + d]; }
    *(LAS h16x8*)(KT + d * 72 + 8 * seg) = kt; *(LAS h16x8*)(VT + d * 72 + 8 * seg) = vt;
    if (seg == 0) HGD[(size_t)u * 64 + d] = __expf(blast);
    __syncthreads();
    if (wave < 4) {
        const int et = wave >> 1, dt = wave & 1, r32 = lane & 31, hi = lane >> 5;
        f32x16 acc = {};
#pragma unroll
        for (int ks = 0; ks < 4; ++ks) {
            const h16x8 a = *(const LAS h16x8*)(VT + (32 * et + r32) * 72 + 16 * ks + 8 * hi);
            const h16x8 bf = *(const LAS h16x8*)(KT + (32 * dt + r32) * 72 + 16 * ks + 8 * hi);
            acc = mfma32(a, bf, acc);
        }
#pragma unroll
        for (int r = 0; r < 16; ++r) HGU[((size_t)u * 64 + 32 * et + crow(r, hi)) * 64 + 32 * dt + r32] = acc[r];
    }
    __syncthreads();
}
__device__ __forceinline__ void hg_out_unit(const Params& p, int layer, int unit, LAS unsigned char* lds) {
    PHASE_IDS();
    const h16* H = (const h16*)(ws + WS_H); h16* MIX = (h16*)(ws + WS_MIX);
    const float* HGU = (const float*)(ws + WS_HGU); const float* HGD = (const float*)(ws + WS_HGD);
    constexpr int NG = NCHUNK / HG_G;
    const int gi = unit % NG, bh = unit / NG, hd = bh % 6, b = bh / 6, c0 = gi * HG_G;
    const int d = tid & 63, seg = tid >> 6, e_own = tid >> 3, d0 = (tid & 7) * 8;
    LAS float* QS = (LAS float*)(lds + HGL_QS); LAS float* KS = (LAS float*)(lds + HGL_KS); LAS float* BS = (LAS float*)(lds + HGL_BS);
    LAS h16* QT = (LAS h16*)(lds + HGL_QT); LAS h16* VT = (LAS h16*)(lds + HGL_VT); LAS h16* ST = (LAS h16*)(lds + HGL_ST); LAS h16* AT = (LAS h16*)(lds + HGL_AT);
    LAS float* OS = (LAS float*)(lds + HGL_OS); LAS float* tot = (LAS float*)(lds + HGL_TOT);
    const float lbv = hg_lb(p, layer, hd * 64 + d);
    const float* nw = p.in[8] + (size_t)layer * 384 + hd * 64;
    float S[8];
#pragma unroll
    for (int j = 0; j < 8; ++j) S[j] = 0.f;
#pragma unroll 4
    for (int cc = 0; cc < c0; ++cc) {
        const size_t uu = (size_t)bh * 64 + cc;
        const f32x4 D0 = *(const f32x4*)(HGD + uu * 64 + d0), D1 = *(const f32x4*)(HGD + uu * 64 + d0 + 4);
        const f32x4 U0 = *(const f32x4*)(HGU + (uu * 64 + e_own) * 64 + d0), U1 = *(const f32x4*)(HGU + (uu * 64 + e_own) * 64 + d0 + 4);
#pragma unroll
        for (int j = 0; j < 4; ++j) { S[j] = D0[j] * S[j] + U0[j]; S[4 + j] = D1[j] * S[4 + j] + U1[j]; }
    }
    for (int c = c0; c < c0 + HG_G; ++c) {
        const int r0 = b * SEQ + 64 * c; const size_t uu = (size_t)bh * 64 + c;
        float bv[8], kv[8], blast;
        hg_prep(H, r0, hd, lbv, d, seg, tot, bv, kv, blast);
        h16x8 vt;
#pragma unroll
        for (int i = 0; i < 8; ++i) {
            const int t = 8 * seg + i;
            const float q = (float)H[(size_t)(r0 + t) * NH + C_HQ + hd * 64 + d];
            QS[t * 68 + d] = q; KS[t * 68 + d] = kv[i]; BS[t * 68 + d] = bv[i];
            QT[t * 72 + d] = (h16)(q * __expf(bv[i]));
            vt[i] = H[(size_t)(r0 + t) * NH + C_HI + hd * 64 + d];
        }
        *(LAS h16x8*)(VT + d * 72 + 8 * seg) = vt;
        { h16x8 st;
#pragma unroll
          for (int j = 0; j < 8; ++j) st[j] = (h16)S[j];
          *(LAS h16x8*)(ST + e_own * 72 + d0) = st; }
        __syncthreads();
        {
            const int t = tid >> 3, s0 = (tid & 7) * 8;
            float a8[8];
#pragma unroll
            for (int j = 0; j < 8; ++j) a8[j] = 0.f;
            if (s0 <= t) {
                for (int d4 = 0; d4 < 16; ++d4) {
                    const f32x4 qq = *(const LAS f32x4*)(QS + t * 68 + 4 * d4), bt = *(const LAS f32x4*)(BS + t * 68 + 4 * d4);
#pragma unroll
                    for (int j = 0; j < 8; ++j) {
                        const f32x4 kk = *(const LAS f32x4*)(KS + (s0 + j) * 68 + 4 * d4), bs = *(const LAS f32x4*)(BS + (s0 + j) * 68 + 4 * d4);
#pragma unroll
                        for (int x = 0; x < 4; ++x) a8[j] += qq[x] * kk[x] * __expf(fminf(bt[x] - bs[x], 0.f));
                    }
                }
            }
            h16x8 av;
#pragma unroll
            for (int j = 0; j < 8; ++j) av[j] = (h16)((s0 + j <= t) ? a8[j] : 0.f);
            *(LAS h16x8*)(AT + t * 72 + s0) = av;
        }
        __syncthreads();
        if (wave < 4) {
            const int et = wave >> 1, tt = wave & 1, r32 = lane & 31, hi = lane >> 5;
            f32x16 acc = {};
#pragma unroll
            for (int ks = 0; ks < 4; ++ks) {
                const h16x8 a = *(const LAS h16x8*)(VT + (32 * et + r32) * 72 + 16 * ks + 8 * hi);
                const h16x8 bf = *(const LAS h16x8*)(AT + (32 * tt + r32) * 72 + 16 * ks + 8 * hi);
                acc = mfma32(a, bf, acc);
            }
#pragma unroll
            for (int ks = 0; ks < 4; ++ks) {
                const h16x8 a = *(const LAS h16x8*)(ST + (32 * et + r32) * 72 + 16 * ks + 8 * hi);
                const h16x8 bf = *(const LAS h16x8*)(QT + (32 * tt + r32) * 72 + 16 * ks + 8 * hi);
                acc = mfma32(a, bf, acc);
            }
#pragma unroll
            for (int r = 0; r < 16; ++r) OS[(32 * tt + r32) * 65 + 32 * et + crow(r, hi)] = acc[r];
        }
        {
            const f32x4 D0 = *(const f32x4*)(HGD + uu * 64 + d0), D1 = *(const f32x4*)(HGD + uu * 64 + d0 + 4);
            const f32x4 U0 = *(const f32x4*)(HGU + (uu * 64 + e_own) * 64 + d0), U1 = *(const f32x4*)(HGU + (uu * 64 + e_own) * 64 + d0 + 4);
#pragma unroll
            for (int j = 0; j < 4; ++j) { S[j] = D0[j] * S[j] + U0[j]; S[4 + j] = D1[j] * S[4 + j] + U1[j]; }
        }
        __syncthreads();
        {
            const int t = tid >> 3, e0 = (tid & 7) * 8;
            float o[8], ssq = 0.f;
#pragma unroll
            for (int j = 0; j < 8; ++j) { o[j] = OS[t * 65 + e0 + j]; ssq += o[j] * o[j]; }
            ssq += __shfl_xor(ssq, 1); ssq += __shfl_xor(ssq, 2); ssq += __shfl_xor(ssq, 4);
            const float rinv = 1.f / sqrtf(ssq * (1.f / 64.f) + 1e-6f);
            const h16x8 z = *(const h16x8*)(H + (size_t)(r0 + t) * NH + C_HZ + hd * 64 + e0);
            const f32x4 w0 = *(const f32x4*)(nw + e0), w1 = *(const f32x4*)(nw + e0 + 4);
            h16x8 ov;
#pragma unroll
            for (int j = 0; j < 8; ++j) { const float zz = (float)z[j]; const float w = j < 4 ? w0[j & 3] : w1[j & 3];
                ov[j] = (h16)(o[j] * rinv * w * (zz / (1.f + __expf(-zz)))); }
            *(h16x8*)(MIX + (size_t)(r0 + t) * DM + 640 + hd * 64 + e0) = ov;
        }
        __syncthreads();
    }
}

constexpr int LDS_BYTES = 147456;
__global__ void __launch_bounds__(512, 2) mega(Params p) {
    extern __shared__ __attribute__((aligned(16))) unsigned char lds_raw[];
    LAS unsigned char* lds = (LAS unsigned char*)lds_raw;
    cg::grid_group grid = cg::this_grid();

    prologue(p, lds);
    grid.sync();
    for (int layer = 0; layer < DEPTH; ++layer) {
        {
            unsigned char* ws = p.ws; asm volatile("" : "+s"(ws)); h16* XH = (h16*)(ws + WS_XH); h16* Hb = (h16*)(ws + WS_H);
            pg8::Gemm g{(const pg8::bf16_t*)XH, (const pg8::bf16_t*)((h16*)(ws + WS_WINT) + (size_t)layer * NH * 1024), MTOK, NH, DM};
            pg8::StaticOrder S; S.init(MTOK, NH, gridDim.x, blockIdx.x);
            pg8::EpiH E{Hb, NH};
            pg8::gemm_phase<pg8::EpiH, pg8::StaticOrder, true, true>(lds, g, S, E);
        }
        grid.sync();
        for (int u = blockIdx.x; u < 256 + 3072; u += gridDim.x) {
            if (u < 256) compress_unit(p, layer, u, lds);
            else hg_state_unit(p, layer, u - 256, lds);
        }
        grid.sync();
        for (int u = blockIdx.x; u < 512 + 512 + 48 * (NCHUNK / HG_G); u += gridDim.x) {
            if (u < 512) nsa_unit(p, u, lds);
            else if (u < 1024) sb_unit(p, u - 512, lds);
            else hg_out_unit(p, layer, u - 1024, lds);
        }
        grid.sync();
        {
            unsigned char* ws = p.ws; asm volatile("" : "+s"(ws)); h16* MIX = (h16*)(ws + WS_MIX); float* Y = (float*)(ws + WS_H);
            pg8::Gemm g{(const pg8::bf16_t*)MIX, (const pg8::bf16_t*)((h16*)(ws + WS_WOUTT) + (size_t)layer * 1024 * 1024), MTOK, DM, DM};
            pg8::StaticOrder S; S.init(MTOK, DM, gridDim.x, blockIdx.x);
            pg8::EpiY E{layer == 0 ? p.in[0] : p.out, Y, ALPHA};
            pg8::gemm_phase<pg8::EpiY, pg8::StaticOrder, true, true>(lds, g, S, E);
        }
        grid.sync();
        ln_phase(p, layer);
        if (layer + 1 < DEPTH) grid.sync();
    }
}

extern "C" void kernel_launch(void* const* d_in, const int* in_sizes, int n_in, void* d_out, int out_size, void* d_ws, size_t ws_size, hipStream_t stream) {
    static int grid = 0;
    if (grid == 0) {
        if (n_in != 13 || ws_size < WS_END) { fprintf(stderr, "kernel_launch: unexpected n_in %d or ws_size %zu (< %zu)\n", n_in, ws_size, (size_t)WS_END); grid = -1; return; }
        int dev = 0, cus = 0, per_cu = 0;
        hipGetDevice(&dev); hipDeviceGetAttribute(&cus, hipDeviceAttributeMultiprocessorCount, dev);
        if (hipFuncSetAttribute((const void*)mega, hipFuncAttributeMaxDynamicSharedMemorySize, LDS_BYTES) != hipSuccess) { fprintf(stderr, "kernel_launch: hipFuncSetAttribute failed\n"); grid = -1; return; }
        if (hipOccupancyMaxActiveBlocksPerMultiprocessor(&per_cu, (const void*)mega, 512, LDS_BYTES) != hipSuccess || per_cu < 1) { fprintf(stderr, "kernel_launch: occupancy query failed (%d)\n", per_cu); (void)hipGetLastError(); per_cu = 1; }
        grid = cus * per_cu;
        fprintf(stderr, "kernel_launch: cus %d per_cu %d grid %d\n", cus, per_cu, grid);
    }
    if (grid < 0) return;
    hipMemsetAsync((char*)d_ws + WS_CTL, 0, CTL_BYTES, stream);
    Params p{};
    for (int i = 0; i < 13; ++i) p.in[i] = (const float*)d_in[i];
    p.out = (float*)d_out; p.ws = (unsigned char*)d_ws;
    void* args[] = {&p};
    hipError_t e = hipLaunchCooperativeKernel((const void*)mega, dim3(grid), dim3(512), args, LDS_BYTES, stream);
    if (e != hipSuccess) fprintf(stderr, "cooperative launch failed: %s (grid %d)\n", hipGetErrorString(e), grid);
}
```

```cpp
#include <hip/hip_runtime.h>
#include <hip/hip_cooperative_groups.h>
#include <cstdio>
#include <cstdint>
namespace cg = cooperative_groups;

#define LAS __attribute__((address_space(3)))
typedef _Float16 h16;
typedef _Float16 h16x8 __attribute__((ext_vector_type(8)));
typedef _Float16 h16x4 __attribute__((ext_vector_type(4)));
typedef _Float16 h16x2 __attribute__((ext_vector_type(2)));
typedef short s16x4 __attribute__((ext_vector_type(4)));
typedef float f32x2 __attribute__((ext_vector_type(2)));
typedef float f32x4 __attribute__((ext_vector_type(4)));
typedef unsigned u32x4 __attribute__((ext_vector_type(4)));
typedef float f32x16 __attribute__((ext_vector_type(16)));
typedef unsigned u32x2 __attribute__((ext_vector_type(2)));

constexpr int NB = 8, SEQ = 4096, DM = 1024, MTOK = NB * SEQ, DEPTH = 2;
constexpr int DIN = 4114, NH = 4352;
constexpr int C_NQ = 0, C_KC = 384, C_VC = 512, C_KS = 640, C_VS = 768, C_KW = 896, C_VW = 1024, C_NZ = 1152;
constexpr int C_SQ = 1536, C_SK = 1792, C_SV = 2048, C_SZ = 2304, C_HQ = 2560, C_HF = 2944, C_HI = 3328, C_HZ = 3712, C_G = 4096;
constexpr float ALPHA = 1.4142135623730951f;
constexpr int NCHUNK = 64;
constexpr int HG_G = 8;

constexpr size_t MiB = 1u << 20;
constexpr size_t WS_CTL = 0;
constexpr size_t CTL_BYTES = 65536;
constexpr size_t WS_WINT = 2 * MiB;
constexpr size_t WS_WOUTT = 20 * MiB;
constexpr size_t WS_WC1T = 24 * MiB;
constexpr size_t WS_WC2T = 26 * MiB;
constexpr size_t WS_PBP = 26 * MiB + 512 * 1024;
constexpr size_t WS_KC = 27 * MiB;
constexpr size_t WS_VCT = 27 * MiB + 512 * 1024;
constexpr size_t WS_HGU = 28 * MiB;
constexpr size_t WS_HGD = 79 * MiB;
constexpr size_t WS_XH = 80 * MiB;
constexpr size_t WS_MIX = 144 * MiB;
constexpr size_t WS_H = 208 * MiB;
constexpr size_t WS_END = 480 * MiB;

struct Params { const float* in[13]; float* out; unsigned char* ws; };

__device__ __forceinline__ unsigned pk2h(float a, float b) { h16x2 v = {(h16)a, (h16)b}; return __builtin_bit_cast(unsigned, v); }
__device__ __forceinline__ float wave_sum(float v) {
#pragma unroll
    for (int o = 1; o < 64; o <<= 1) v += __shfl_xor(v, o);
    return v;
}
__device__ __forceinline__ float xhalf(float x, int hi) {
    auto r = __builtin_amdgcn_permlane32_swap(__float_as_uint(x), __float_as_uint(x), false, false);
    return __uint_as_float(hi ? r[0] : r[1]);
}
__device__ __forceinline__ f32x16 mfma32(h16x8 a, h16x8 b, f32x16 c) { return __builtin_amdgcn_mfma_f32_32x32x16_f16(a, b, c, 0, 0, 0); }
__device__ __forceinline__ f32x4 mfma16(h16x8 a, h16x8 b, f32x4 c) { return __builtin_amdgcn_mfma_f32_16x16x32_f16(a, b, c, 0, 0, 0); }
__device__ __forceinline__ int crow(int r, int hi) { return (r & 3) + 8 * (r >> 2) + 4 * hi; }
namespace pg8 {
#define PG8_LAS __attribute__((address_space(3)))
typedef unsigned short bf16_t;
typedef short bf16x8 __attribute__((ext_vector_type(8)));
typedef float f32x4 __attribute__((ext_vector_type(4)));
typedef unsigned u32x4 __attribute__((ext_vector_type(4)));
constexpr int BM = 256, BK = 64, HALF = 128, HTB = HALF * BK * 2  , STAGE_BYTES = 8 * HTB, NXCD = 8, WGM = 8;

__host__ __device__ __forceinline__ int lds_byte(int r, int c) { const int st = (r >> 4) * 2 + (c >> 5), rr = r & 15, cc = c & 31, ob = rr * 64 + cc * 2; return st * 1024 + (ob ^ (((ob >> 9) & 1) << 5)); }
__host__ __device__ __forceinline__ void stage_rc(int b, int& R, int& C) { const int st = b / 1024, sb = b % 1024, swz = sb ^ (((sb >> 9) & 1) << 5); R = (st >> 1) * 16 + swz / 64; C = (st & 1) * 32 + (swz % 64) / 2; }
__host__ __device__ __forceinline__ int perm32(int rho) { const int n = rho >> 4, i = rho & 15; return 8 * (i >> 2) + 4 * n + (i & 3); }

struct Unit { int pm, pn; };
struct Gemm { const bf16_t* A; const bf16_t* Bt; int M, N, K; };

struct StaticOrder {
    int nM, nN, nwg, G, c;
    __host__ __device__ void init(int M, int N, int G_, int c_) { nM = M / BM; nN = N / BM; nwg = nM * nN; G = G_; c = c_; }
    __host__ __device__ bool next(int i, Unit& u) const {
        const long L = (long)i * G + c; if (L >= nwg) return false;
        int wgid = (int)L; { const int q = nwg / NXCD, r = nwg % NXCD, xcd = wgid % NXCD, off = wgid / NXCD; wgid = (xcd < r ? xcd * (q + 1) : r * (q + 1) + (xcd - r) * q) + off; }
        const int nig = WGM * nN, gid = wgid / nig, fm = gid * WGM, gsz = (nM - fm) < WGM ? (nM - fm) : WGM;
        u.pm = fm + ((wgid % nig) % gsz); u.pn = (wgid % nig) / gsz; return true;
    }
    __device__ __forceinline__ void a_ready(const Unit&) const {}
    __device__ __forceinline__ void done(const Unit&) const {}
};

struct EpiH {
    static constexpr bool PERM = true, AFTER_DRAIN = false;
    _Float16* O; int ldc;
    __device__ __forceinline__ void operator()(const f32x4 (&acc)[2][2][4][2], const Unit& u, int wr, int wc, int fr, int fq) const {
        const int row0 = u.pm * BM + wr * 64 + fr; const int col0 = u.pn * BM + wc * 32 + 8 * fq;
#pragma unroll
        for (int ai = 0; ai < 2; ++ai)
#pragma unroll
            for (int m = 0; m < 4; ++m) { _Float16* rowp = O + (size_t)(row0 + ai * HALF + m * 16) * ldc + col0;
#pragma unroll
                for (int bj = 0; bj < 2; ++bj) { const f32x4 v0 = acc[ai][bj][m][0], v1 = acc[ai][bj][m][1];
                    u32x4 w; w.x = pk2h(v0[0], v0[1]); w.y = pk2h(v0[2], v0[3]); w.z = pk2h(v1[0], v1[1]); w.w = pk2h(v1[2], v1[3]);
                    *(u32x4*)(rowp + bj * HALF) = w; } }
    }
};
struct EpiY {
    static constexpr bool PERM = false, AFTER_DRAIN = false;
    const float* base; float* out; float alpha;
    __device__ __forceinline__ void operator()(const f32x4 (&acc)[2][2][4][2], const Unit& u, int wr, int wc, int fr, int fq) const {
        const int col0 = u.pn * BM + wc * 32 + 4 * fq;
#pragma unroll
        for (int ai = 0; ai < 2; ++ai)
#pragma unroll
            for (int m = 0; m < 4; ++m) { const int r = u.pm * BM + ai * HALF + wr * 64 + m * 16 + fr; const size_t off = (size_t)r * 1024 + col0;
#pragma unroll
                for (int bj = 0; bj < 2; ++bj)
#pragma unroll
                    for (int n = 0; n < 2; ++n) { const f32x4 bs = *(const f32x4*)(base + off + bj * HALF + n * 16); *(f32x4*)(out + off + bj * HALF + n * 16) = acc[ai][bj][m][n] + bs * alpha; } }
    }
};
template <class Epi, class Sched, bool ALIGN_EPI = false, bool SP2 = false>
__device__ __forceinline__ void gemm_phase(PG8_LAS unsigned char* lds, const Gemm g, const Sched& S, const Epi& E, int wv) {
    int lane0_ = __builtin_amdgcn_mbcnt_hi(~0u, __builtin_amdgcn_mbcnt_lo(~0u, 0u)); asm volatile("" : "+v"(lane0_)); const int tid_ = wv * 64 + lane0_;
    const int tid = tid_, wid = __builtin_amdgcn_readfirstlane(tid >> 6), lane = tid & 63, wr = wid >> 2, wc = wid & 3, fr = lane & 15, fq = lane >> 4;
    const int K = g.K, nt = K / BK;
    unsigned voffA[2], voffB[2];
#pragma unroll
    for (int i = 0; i < 2; ++i) { int R, C; stage_rc(tid * 16 + i * 8192, R, C); const int Rb = Epi::PERM ? ((R & ~31) + perm32(R & 31)) : R;
        voffA[i] = (unsigned)(R * K + C) * 2u; voffB[i] = (unsigned)(Rb * K + C) * 2u; }
    const size_t kstep = (size_t)(BK * 2);
    const size_t hstep = (size_t)HALF * K * 2;
    const size_t tstep = 2 * hstep;
    const unsigned ldsw = (unsigned)wid * 1024u;
    const int aoff = lds_byte(wr * 64 + fr, fq * 8), boff = lds_byte(wc * 32 + fr, fq * 8);
#define PG8_SA(b, h) (((b) * 2 + (h)) * HTB)
#define PG8_SB(b, h) ((4 + (b) * 2 + (h)) * HTB)
#define PG8_STAGE(bufoff, gbase, voff) do { _Pragma("unroll") for (int _i = 0; _i < 2; ++_i) \
        __builtin_amdgcn_global_load_lds((const unsigned*)((const char*)(gbase) + (voff)[_i]), (PG8_LAS unsigned*)(lds + (bufoff) + ldsw + _i * 8192), 16, 0, 0); } while (0)
#define PG8_LDA(dst, b, h) do { _Pragma("unroll") for (int m = 0; m < 4; ++m) _Pragma("unroll") for (int k = 0; k < 2; ++k) dst[m][k] = *(const PG8_LAS bf16x8*)(lds + PG8_SA(b, h) + aoff + m * 2048 + k * 1024); } while (0)
#define PG8_LDB(dst, b, h) do { _Pragma("unroll") for (int n = 0; n < 2; ++n) _Pragma("unroll") for (int k = 0; k < 2; ++k) dst[n][k] = *(const PG8_LAS bf16x8*)(lds + PG8_SB(b, h) + boff + n * 2048 + k * 1024); } while (0)
#define PG8_MMA(ai, bj, At, Bt) do { __builtin_amdgcn_s_setprio(1); _Pragma("unroll") for (int m = 0; m < 4; ++m) _Pragma("unroll") for (int n = 0; n < 2; ++n) _Pragma("unroll") for (int k = 0; k < 2; ++k) \
        acc[ai][bj][m][n] = __builtin_amdgcn_mfma_f32_16x16x32_f16(__builtin_bit_cast(h16x8, Bt[n][k]), __builtin_bit_cast(h16x8, At[m][k]), acc[ai][bj][m][n], 0, 0, 0); __builtin_amdgcn_s_setprio(0); } while (0)
#define PG8_WAIT_V(n) asm volatile("s_waitcnt vmcnt(" #n ")" ::: "memory")
#define PG8_WAIT_L(n) asm volatile("s_waitcnt lgkmcnt(" #n ")" ::: "memory")
#define PG8_BAR __builtin_amdgcn_s_barrier()
#define PG8_SCHED __builtin_amdgcn_sched_barrier(0)
    Unit cur, nxt; int ui = 0;
    if (!S.next(0, cur)) return;
    f32x4 acc[2][2][4][2];
#pragma unroll
    for (int a = 0; a < 2; ++a)
#pragma unroll
        for (int b = 0; b < 2; ++b)
#pragma unroll
            for (int m = 0; m < 4; ++m)
#pragma unroll
                for (int n = 0; n < 2; ++n) acc[a][b][m][n] = (f32x4){0.f, 0.f, 0.f, 0.f};
    bf16x8 At[4][2], B0[2][2], B1[2][2];
    const char* cA = (const char*)g.A + (size_t)cur.pm * tstep; const char* cB = (const char*)g.Bt + (size_t)cur.pn * tstep;
    S.a_ready(cur);
    if constexpr (SP2) {
        PG8_STAGE(PG8_SB(0, 0), cB, voffB); PG8_STAGE(PG8_SB(0, 1), cB + hstep, voffB); PG8_STAGE(PG8_SA(0, 0), cA, voffA); PG8_STAGE(PG8_SA(0, 1), cA + hstep, voffA);
        if (wr == 1) PG8_BAR;
        PG8_WAIT_V(2); PG8_BAR;
        PG8_STAGE(PG8_SB(1, 0), cB + kstep, voffB); PG8_STAGE(PG8_SA(1, 0), cA + kstep, voffA); PG8_STAGE(PG8_SB(1, 1), cB + hstep + kstep, voffB);
        PG8_WAIT_V(6); PG8_BAR;
    } else {
        PG8_STAGE(PG8_SB(0, 0), cB, voffB); PG8_STAGE(PG8_SA(0, 0), cA, voffA); PG8_STAGE(PG8_SB(0, 1), cB + hstep, voffB); PG8_STAGE(PG8_SA(0, 1), cA + hstep, voffA);
        if (wr == 1) PG8_BAR;
        PG8_WAIT_V(4); PG8_BAR;
        PG8_STAGE(PG8_SB(1, 0), cB + kstep, voffB); PG8_STAGE(PG8_SA(1, 0), cA + kstep, voffA); PG8_STAGE(PG8_SB(1, 1), cB + hstep + kstep, voffB);
        PG8_WAIT_V(6); PG8_BAR;
    }
    for (;;) {
        const bool has_next = S.next(ui + 1, nxt);
        const char* nA = has_next ? (const char*)g.A + (size_t)nxt.pm * tstep : cA; const char* nB = has_next ? (const char*)g.Bt + (size_t)nxt.pn * tstep : cB;
        for (int t = 0; t < nt; t += 2) {
            const bool last = (t == nt - 2);
            const char* a1 = cA + (size_t)(t + 1) * kstep;
            const char* a2 = last ? nA : cA + (size_t)(t + 2) * kstep; const char* b2 = last ? nB : cB + (size_t)(t + 2) * kstep;
            const char* a3 = a2 + kstep; const char* b3 = b2 + kstep;
            if (last && has_next) S.a_ready(nxt);
            if constexpr (SP2) {
            PG8_LDB(B0, 0, 0); PG8_LDB(B1, 0, 1); PG8_SCHED; PG8_LDA(At, 0, 0); PG8_STAGE(PG8_SA(1, 1), a1 + hstep, voffA);
            PG8_WAIT_V(8); PG8_WAIT_L(0); PG8_BAR; PG8_MMA(0, 0, At, B0); PG8_MMA(0, 1, At, B1); PG8_BAR; PG8_SCHED;
            PG8_LDA(At, 0, 1); PG8_STAGE(PG8_SB(0, 0), b2, voffB); PG8_STAGE(PG8_SB(0, 1), b2 + hstep, voffB); PG8_STAGE(PG8_SA(0, 0), a2, voffA);
            PG8_WAIT_V(8); PG8_WAIT_L(0); PG8_BAR; PG8_MMA(1, 0, At, B0); PG8_MMA(1, 1, At, B1); PG8_BAR; PG8_SCHED;
            PG8_LDB(B0, 1, 0); PG8_LDB(B1, 1, 1); PG8_SCHED; PG8_LDA(At, 1, 0); PG8_STAGE(PG8_SA(0, 1), a2 + hstep, voffA);
            PG8_WAIT_V(8); PG8_WAIT_L(0); PG8_BAR; PG8_MMA(0, 0, At, B0); PG8_MMA(0, 1, At, B1); PG8_BAR; PG8_SCHED;
            PG8_LDA(At, 1, 1); PG8_STAGE(PG8_SB(1, 0), b3, voffB); PG8_STAGE(PG8_SB(1, 1), b3 + hstep, voffB); PG8_STAGE(PG8_SA(1, 0), a3, voffA);
            PG8_WAIT_V(8); PG8_WAIT_L(0); PG8_BAR; PG8_MMA(1, 0, At, B0); PG8_MMA(1, 1, At, B1); PG8_BAR; PG8_SCHED;
            } else {
            PG8_LDB(B0, 0, 0); PG8_SCHED; PG8_LDA(At, 0, 0); PG8_STAGE(PG8_SA(1, 1), a1 + hstep, voffA);
            PG8_WAIT_L(8); PG8_BAR; PG8_WAIT_L(0); PG8_MMA(0, 0, At, B0); PG8_BAR; PG8_SCHED;
            PG8_LDB(B1, 0, 1); PG8_STAGE(PG8_SB(0, 0), b2, voffB);
            PG8_BAR; PG8_WAIT_L(0); PG8_MMA(0, 1, At, B1); PG8_BAR;
            PG8_LDA(At, 0, 1); PG8_STAGE(PG8_SA(0, 0), a2, voffA);
            PG8_BAR; PG8_WAIT_L(0); PG8_MMA(1, 0, At, B0); PG8_BAR; PG8_SCHED;
            PG8_STAGE(PG8_SB(0, 1), b2 + hstep, voffB);
            PG8_WAIT_V(6); PG8_BAR; PG8_MMA(1, 1, At, B1); PG8_BAR;
            PG8_LDB(B0, 1, 0); PG8_SCHED; PG8_LDA(At, 1, 0); PG8_STAGE(PG8_SA(0, 1), a2 + hstep, voffA);
            PG8_WAIT_L(8); PG8_BAR; PG8_WAIT_L(0); PG8_MMA(0, 0, At, B0); PG8_BAR; PG8_SCHED;
            PG8_LDB(B1, 1, 1); PG8_STAGE(PG8_SB(1, 0), b3, voffB);
            PG8_BAR; PG8_WAIT_L(0); PG8_MMA(0, 1, At, B1); PG8_BAR;
            PG8_LDA(At, 1, 1); PG8_STAGE(PG8_SA(1, 0), a3, voffA);
            PG8_BAR; PG8_WAIT_L(0); PG8_MMA(1, 0, At, B0); PG8_BAR; PG8_SCHED;
            PG8_STAGE(PG8_SB(1, 1), b3 + hstep, voffB);
            PG8_WAIT_V(6); PG8_BAR; PG8_MMA(1, 1, At, B1); PG8_BAR;
            }
        }
        if constexpr (ALIGN_EPI) { if (wr == 0) PG8_BAR; }
        if constexpr (!Epi::AFTER_DRAIN) { E(acc, cur, wr, wc, fr, fq); S.done(cur); }
        if (!has_next) break;
#pragma unroll
        for (int a = 0; a < 2; ++a)
#pragma unroll
            for (int b = 0; b < 2; ++b)
#pragma unroll
                for (int m = 0; m < 4; ++m)
#pragma unroll
                    for (int n = 0; n < 2; ++n) acc[a][b][m][n] = (f32x4){0.f, 0.f, 0.f, 0.f};
        cur = nxt; cA = nA; cB = nB; ++ui;
        if constexpr (ALIGN_EPI) { if (wr == 1) PG8_BAR; }
    }
    PG8_WAIT_V(0);
    if constexpr (!ALIGN_EPI) { if (wr == 0) PG8_BAR; }
    PG8_BAR;
    if constexpr (Epi::AFTER_DRAIN) { E.fused(acc, cur, wr, wc, fr, fq, lds, wid, lane); S.done(cur); }
#undef PG8_SA
#undef PG8_SB
#undef PG8_STAGE
#undef PG8_LDA
#undef PG8_LDB
#undef PG8_MMA
#undef PG8_WAIT_V
#undef PG8_WAIT_L
#undef PG8_BAR
#undef PG8_SCHED
}
}

#define XB_TMO      128
#define XB_XCNT(j)  (256  + 64 * (j))
#define XB_XSUB(j)  (1280 + 64 * (j))
#define XB_XGEN(j)  (2304 + 64 * (j))
#define XB_TOP      3328
#define XB_TOPGEN   3392
#define XCD_BAR_WORDS 3456
#define XB_SPIN_CAP (1u << 18)

__device__ __forceinline__ unsigned xb_ld(unsigned* p)              { return __hip_atomic_load(p, __ATOMIC_RELAXED, __HIP_MEMORY_SCOPE_AGENT); }
__device__ __forceinline__ unsigned xb_add(unsigned* p, unsigned v) { return __hip_atomic_fetch_add(p, v, __ATOMIC_RELAXED, __HIP_MEMORY_SCOPE_AGENT); }
__device__ __forceinline__ unsigned xb_xcc_id() { return (unsigned)__builtin_amdgcn_s_getreg((3 << 11) | 20) & 0xFu; }
#define XB_SPIN(cond, bar) do { unsigned _sp = 0; while (cond) { __builtin_amdgcn_s_sleep(1); \
    if ((++_sp & 255u) == 0u) { if (xb_ld(&(bar)[XB_TMO])) break; if (_sp > XB_SPIN_CAP) { atomicAdd(&(bar)[XB_TMO], 1u); break; } } } } while (0)

struct XcdBarrier {
    unsigned* bar; unsigned x;
    volatile LAS unsigned* st;
};

__device__ __forceinline__ XcdBarrier xcd_barrier_post(unsigned* bar, volatile LAS unsigned* st) {
    XcdBarrier b; b.bar = bar; b.x = xb_xcc_id(); b.st = st;
    if (threadIdx.x == 0) (void)xb_add(&bar[XB_XCNT(b.x)], 1u);
    return b;
}
__device__ __forceinline__ void xcd_barrier_complete(unsigned* bar, unsigned x, unsigned& nloc, unsigned& nx) {
    const unsigned G = gridDim.x * gridDim.y * gridDim.z;
    unsigned sum, cnt, mine, sp = 0u;
    for (;;) {
        sum = 0u; cnt = 0u; mine = 0u;
#pragma unroll
        for (unsigned j = 0; j < 16; ++j) { const unsigned c = xb_ld(&bar[XB_XCNT(j)]); sum += c; cnt += (c > 0u) ? 1u : 0u; mine = (j == x) ? c : mine; }
        if (sum == G) break;
        __builtin_amdgcn_s_sleep(1);
        if ((++sp & 255u) == 0u) { if (xb_ld(&bar[XB_TMO])) break; if (sp > XB_SPIN_CAP) { atomicAdd(&bar[XB_TMO], 1u); break; } }
    }
    nloc = mine > 0u ? mine : 1u; nx = cnt > 0u ? cnt : 1u;
}

__device__ __forceinline__ void xcd_barrier(const XcdBarrier& b, int wv) {
    asm volatile("s_waitcnt vmcnt(0)" ::: "memory");
    __syncthreads();
    if (wv == 0 && __builtin_amdgcn_mbcnt_hi(~0u, __builtin_amdgcn_mbcnt_lo(~0u, 0u)) == 0) {
        unsigned* bar = b.bar;
        __builtin_amdgcn_s_waitcnt(0);
        unsigned nloc = b.st[0], nx = b.st[1];
        if (nloc == 0u) { xcd_barrier_complete(bar, b.x, nloc, nx); b.st[0] = nloc; b.st[1] = nx; }
        const unsigned old = xb_add(&bar[XB_XSUB(b.x)], 1u);
        const unsigned gen = old / nloc;
        if (old + 1u == (gen + 1u) * nloc) {
            __builtin_amdgcn_fence(__ATOMIC_RELEASE, "agent");
            asm volatile("s_waitcnt vmcnt(0)" ::: "memory");
            const unsigned og = xb_add(&bar[XB_TOP], 1u);
            const unsigned tg = og / nx;
            if (og + 1u == (tg + 1u) * nx) xb_add(&bar[XB_TOPGEN], 1u);
            else XB_SPIN(xb_ld(&bar[XB_TOPGEN]) == tg, bar);
            __builtin_amdgcn_fence(__ATOMIC_ACQUIRE, "agent");
            xb_add(&bar[XB_XGEN(b.x)], 1u);
            asm volatile("s_waitcnt vmcnt(0)" ::: "memory");
        } else {
            XB_SPIN(xb_ld(&bar[XB_XGEN(b.x)]) == gen, bar);
            __builtin_amdgcn_fence(__ATOMIC_ACQUIRE, "agent");
            asm volatile("s_waitcnt vmcnt(0)" ::: "memory");
        }
    }
    __syncthreads();
}

#define PHASE_IDS() int lane_ = __builtin_amdgcn_mbcnt_hi(~0u, __builtin_amdgcn_mbcnt_lo(~0u, 0u)); asm volatile("" : "+v"(lane_)); const int lane = lane_, wave = wv, tid = wv * 64 + lane_; (void)lane; (void)wave; (void)tid; unsigned char* ws = p.ws; asm volatile("" : "+s"(ws))
typedef short v4i16_t __attribute__((ext_vector_type(4)));
__device__ __forceinline__ h16x4 tr_read4(const LAS unsigned char* p) { return __builtin_bit_cast(h16x4, __builtin_amdgcn_ds_read_tr16_b64_v4i16((LAS v4i16_t*)p)); }
__device__ __forceinline__ h16x8 vt_frag(const LAS unsigned char* vimg, int half_bytes, int et, int st, int lane) {
    const int hi = lane >> 5, blk = (lane >> 4) & 1, q = (lane & 15) >> 2, pp = lane & 3;
    const LAS unsigned char* a = vimg + et * half_bytes + (16 * st + 4 * hi + q) * 64 + (16 * blk + 4 * pp) * 2;
    const h16x4 lo = tr_read4(a), hh = tr_read4(a + 8 * 64);
    return (h16x8){lo[0], lo[1], lo[2], lo[3], hh[0], hh[1], hh[2], hh[3]};
}
__device__ __forceinline__ float silu_f(float z) { return z / (1.f + __expf(-z)); }

constexpr int SBL_K = 0, SBL_KB = 4608, SBL_V = 9216, SBL_VB = 4096, SBL_FLAG = 17408;
__device__ __forceinline__ void sb_unit(const Params& p, int unit, LAS unsigned char* lds, int wv) {
    PHASE_IDS();
    const h16* H = (const h16*)(ws + WS_H); h16* MIX = (h16*)(ws + WS_MIX);
    const int qb = unit & 15, bh = unit >> 4, hh = bh & 3, b = bh >> 2;
    const int r32 = lane & 31, hi = lane >> 5;
    const int t0 = 256 * qb, tb = t0 + 32 * wave, Ttop = 8 * qb + 7, Tdiag = 8 * qb + wave;
    LAS int* flags = (LAS int*)(lds + SBL_FLAG);
    const size_t qrow = (size_t)(b * SEQ + tb + r32) * NH;
    h16x8 qf[4];
#pragma unroll
    for (int ks = 0; ks < 4; ++ks) { qf[ks] = *(const h16x8*)(H + qrow + C_SQ + hh * 64 + 16 * ks + 8 * hi); qf[ks] = qf[ks] * (h16)0.125f; }
    f32x16 o0 = {}, o1 = {};
    float R = 1.f; bool done = false;
    const int li = tid & 255, lrow = li >> 3, lc = li & 7; const bool isV = tid >= 256;
    const h16* gsrc = H + (size_t)(b * SEQ + lrow) * NH + (isV ? C_SV : C_SK) + hh * 64 + 8 * lc;
    const int ldst = isV ? SBL_V + (lc >> 2) * 2048 + lrow * 64 + (lc & 3) * 16 : SBL_K + lrow * 144 + lc * 16;
    const int lbuf = isV ? SBL_VB : SBL_KB;
    { const u32x4 v = *(const u32x4*)(gsrc + (size_t)Ttop * 32 * NH); *(LAS u32x4*)(lds + ldst) = v; }
    __syncthreads();
    int buf = 0, it = 0;
    for (int T = Ttop; T >= 0; --T, ++it) {
        u32x4 nxt = {0u, 0u, 0u, 0u};
        if (T > 0) nxt = *(const u32x4*)(gsrc + (size_t)(T - 1) * 32 * NH);
        if (T <= Tdiag && !done) {
            const LAS unsigned char* kimg = lds + SBL_K + buf * SBL_KB; const LAS unsigned char* vimg = lds + SBL_V + buf * SBL_VB;
            f32x16 z = {};
#pragma unroll
            for (int ks = 0; ks < 4; ++ks) { const h16x8 kf = *(const LAS h16x8*)(kimg + r32 * 144 + (16 * ks + 8 * hi) * 2); z = mfma32(kf, qf[ks], z); }
            float om[16], be[16];
            const bool diag = (T == Tdiag);
#pragma unroll
            for (int r = 0; r < 16; ++r) {
                const float u = __expf(fminf(z[r], 80.f)), rr = __builtin_amdgcn_rcpf(1.f + u);
                const bool valid = !diag || (crow(r, hi) < r32);
                om[r] = valid ? rr : 1.f; be[r] = valid ? u * rr : 0.f;
            }
            float G[4], Gp[4];
#pragma unroll
            for (int g = 0; g < 4; ++g) { G[g] = (om[4 * g] * om[4 * g + 1]) * (om[4 * g + 2] * om[4 * g + 3]); Gp[g] = xhalf(G[g], hi); }
            float E[4]; float run = R;
#pragma unroll
            for (int g = 3; g >= 0; --g) { E[g] = hi ? run : run * Gp[g]; run = run * (G[g] * Gp[g]); }
            h16x8 pf[2];
#pragma unroll
            for (int g = 0; g < 4; ++g) {
                const float w3 = E[g], w2 = w3 * om[4 * g + 3], w1 = w2 * om[4 * g + 2], w0 = w1 * om[4 * g + 1];
                pf[g >> 1][4 * (g & 1) + 0] = (h16)(be[4 * g + 0] * w0); pf[g >> 1][4 * (g & 1) + 1] = (h16)(be[4 * g + 1] * w1);
                pf[g >> 1][4 * (g & 1) + 2] = (h16)(be[4 * g + 2] * w2); pf[g >> 1][4 * (g & 1) + 3] = (h16)(be[4 * g + 3] * w3);
            }
            R = run;
#pragma unroll
            for (int st = 0; st < 2; ++st) {
                o0 = mfma32(vt_frag(vimg, 2048, 0, st, lane), pf[st], o0);
                o1 = mfma32(vt_frag(vimg, 2048, 1, st, lane), pf[st], o1);
            }
            done = (__builtin_amdgcn_ballot_w64(R >= 1e-37f) == 0ull);
        }
        if (T > 0) *(LAS u32x4*)(lds + ldst + (buf ^ 1) * lbuf) = nxt;
        if (lane == 0) flags[(it & 1) * 8 + wave] = done ? 1 : 0;
        __syncthreads();
        int alld = 1;
#pragma unroll
        for (int w = 0; w < 8; ++w) alld &= flags[(it & 1) * 8 + w];
        if (alld) break;
        buf ^= 1;
    }
#pragma unroll
    for (int et = 0; et < 2; ++et)
#pragma unroll
        for (int g = 0; g < 4; ++g) {
            const int e = 32 * et + 8 * g + 4 * hi;
            const h16x4 zz = *(const h16x4*)(H + qrow + C_SZ + hh * 64 + e);
            h16x4 ov;
#pragma unroll
            for (int i = 0; i < 4; ++i) { const float ov_f = (et ? o1[4 * g + i] : o0[4 * g + i]); ov[i] = (h16)(ov_f * silu_f((float)zz[i])); }
            *(h16x4*)(MIX + (size_t)(b * SEQ + tb + r32) * DM + 384 + hh * 64 + e) = ov;
        }
    __syncthreads();
}

constexpr int NSL_K = 0, NSL_KB = 9216, NSL_V = 18432, NSL_VB = 8192, NSL_BT = 34816, NSL_IMP = 36864, NSL_Q = NSL_IMP + 8 * 16 * 65 * 4, NSL_END = NSL_Q + 8 * 6 * 1024;
constexpr int REP_SEL = 1, REP_WIN = 1;
constexpr float NSA_NEG = -1e30f, NSA_MINIT = -1e20f, NSA_THR = 10.f;
struct NsaW { const LAS h16x8* qf; f32x4 o[3][4]; float m[3], l[3]; };
__device__ __forceinline__ float max4(float v, int hi) { v = fmaxf(v, __shfl_xor(v, 16)); return fmaxf(v, xhalf(v, hi)); }
__device__ __forceinline__ float sum4(float v, int hi) { v += __shfl_xor(v, 16); return v + xhalf(v, hi); }

template <int MODE>
__device__ __forceinline__ void nsa_pass(NsaW& W, const h16* kbase, const h16* vbase, int pitch, int kt_lo, int kt_hi, int tw, int t, unsigned long long sel,
                                         LAS unsigned char* lds, const LAS float* BT, LAS float* impw, int tid, int lane, int wave) {
    const int fr = lane & 15, kq = lane >> 4, hi = lane >> 5;
    const int lc = tid & 7, lr0 = tid >> 3, maxrow = 32 * kt_hi + 31;
    const int kdst0 = NSL_K + lr0 * 144 + lc * 16;
    const int vdst0 = NSL_V + (lr0 >> 5) * 4096 + (lc >> 2) * 2048 + (lr0 & 31) * 64 + (lc & 3) * 16;
    const int stg_lo = kt_lo >> 1, stg_hi = kt_hi >> 1;
#define NSA_STAGE_LOAD(stg, k0, v0) do { int r0_ = 64 * (stg) + lr0; r0_ = r0_ > maxrow ? maxrow : r0_; \
        k0 = *(const u32x4*)(kbase + (size_t)r0_ * pitch + 8 * lc); v0 = *(const u32x4*)(vbase + (size_t)r0_ * pitch + 8 * lc); } while (0)
#define NSA_STAGE_STORE(b, k0, v0) do { *(LAS u32x4*)(lds + kdst0 + (b) * NSL_KB) = k0; *(LAS u32x4*)(lds + vdst0 + (b) * NSL_VB) = v0; } while (0)
    { u32x4 k0, v0; NSA_STAGE_LOAD(stg_lo, k0, v0); NSA_STAGE_STORE(0, k0, v0); }
    __syncthreads();
    int buf = 0; float prev_carry = 0.f;
    for (int stg = stg_lo; stg <= stg_hi; ++stg) {
        u32x4 nk0 = {0u, 0u, 0u, 0u}, nv0 = nk0;
        if (stg < stg_hi) NSA_STAGE_LOAD(stg + 1, nk0, nv0);
      for (int h2 = 0; h2 < 2; ++h2) {
        const int kt = 2 * stg + h2;
        bool act = (kt >= kt_lo) && (kt <= kt_hi);
        if (MODE <= 1) act = act && (512 * kt + 16 <= tw);
        else if (MODE == 2) act = act && (32 * kt <= tw + 15) && (__builtin_amdgcn_ballot_w64((sel >> stg) & 1ull) != 0ull);
        else act = act && !(32 * kt + 31 < tw - 511 || 32 * kt > tw + 15);
        if (act) {
            const LAS unsigned char* kimg = lds + NSL_K + buf * NSL_KB + h2 * (32 * 144); const LAS unsigned char* vimg = lds + NSL_V + buf * NSL_VB + h2 * 4096;
            h16x8 kf[2][2];
#pragma unroll
            for (int sub = 0; sub < 2; ++sub)
#pragma unroll
                for (int ks = 0; ks < 2; ++ks) kf[sub][ks] = *(const LAS h16x8*)(kimg + (16 * sub + fr) * 144 + (32 * ks + 8 * kq) * 2);
            h16x8 vf[4];
            if (MODE != 0) {
#pragma unroll
                for (int et = 0; et < 4; ++et) {
                    const LAS unsigned char* a = vimg + (et >> 1) * 2048 + (4 * kq + ((lane & 15) >> 2)) * 64 + (16 * (et & 1) + 4 * (lane & 3)) * 2;
                    const h16x4 lo = tr_read4(a), hh4 = tr_read4(a + 16 * 64);
                    vf[et] = (h16x8){lo[0], lo[1], lo[2], lo[3], hh4[0], hh4[1], hh4[2], hh4[3]};
                }
            }
            const bool selbit = (MODE == 2) ? (((sel >> stg) & 1ull) != 0ull) : true;
            const bool farflag = (MODE >= 2) && (tw - (32 * kt + 31) >= 113) && (MODE == 2 || (tw + 15 - 32 * kt) < 512);
            float Lloc[2] = {0.f, 0.f}, Llast[2] = {0.f, 0.f};
#pragma unroll
            for (int hh = 0; hh < 3; ++hh) {
                f32x4 s[2]; const h16x8 q0 = W.qf[(hh * 2 + 0) * 64 + lane], q1 = W.qf[(hh * 2 + 1) * 64 + lane];
#pragma unroll
                for (int sub = 0; sub < 2; ++sub) { s[sub] = (f32x4){0.f, 0.f, 0.f, 0.f}; s[sub] = mfma16(kf[sub][0], q0, s[sub]); s[sub] = mfma16(kf[sub][1], q1, s[sub]); }
                if (farflag) { const float cb = selbit ? BT[hh * 128 + 127] : NSA_NEG;
#pragma unroll
                    for (int sub = 0; sub < 2; ++sub)
#pragma unroll
                        for (int r = 0; r < 4; ++r) s[sub][r] += cb;
                } else {
                    float bb[2][4];
#pragma unroll
                    for (int sub = 0; sub < 2; ++sub)
#pragma unroll
                        for (int r = 0; r < 4; ++r) {
                            const int key = 32 * kt + 16 * sub + 4 * kq + r;
                            const int rel = (MODE <= 1) ? t - (16 * key + 31) : t - key;
                            const int ri = rel < 0 ? 0 : (rel > 127 ? 127 : rel);
                            bb[sub][r] = ((const volatile LAS float*)BT)[hh * 128 + ri];
                        }
#pragma unroll
                    for (int sub = 0; sub < 2; ++sub)
#pragma unroll
                        for (int r = 0; r < 4; ++r) {
                            const int key = 32 * kt + 16 * sub + 4 * kq + r;
                            const int rel = (MODE <= 1) ? t - (16 * key + 31) : t - key;
                            bool v = rel >= 0;
                            if (MODE == 2) v = v && selbit;
                            if (MODE == 3) v = v && rel < 512;
                            s[sub][r] = v ? s[sub][r] + bb[sub][r] : NSA_NEG;
                        }
                }
                const float lm = fmaxf(fmaxf(fmaxf(s[0][0], s[0][1]), fmaxf(s[0][2], s[0][3])), fmaxf(fmaxf(s[1][0], s[1][1]), fmaxf(s[1][2], s[1][3])));
                if (MODE == 0) {
                    const float mn = fmaxf(W.m[hh], lm); float ps = 0.f;
#pragma unroll
                    for (int sub = 0; sub < 2; ++sub)
#pragma unroll
                        for (int r = 0; r < 4; ++r) ps += (s[sub][r] > -1e29f) ? __builtin_amdgcn_exp2f(s[sub][r] - mn) : 0.f;
                    W.l[hh] = W.l[hh] * __builtin_amdgcn_exp2f(W.m[hh] - mn) + ps; W.m[hh] = mn;
                } else {
                    if (MODE == 1) {
#pragma unroll
                        for (int sub = 0; sub < 2; ++sub) {
#pragma unroll
                            for (int r = 0; r < 4; ++r) { s[sub][r] = (s[sub][r] > -1e29f) ? __builtin_amdgcn_exp2f(s[sub][r] - W.m[hh]) * W.l[hh] : 0.f; Lloc[sub] += s[sub][r]; }
                            Llast[sub] += s[sub][3]; }
                    } else {
                        if (__builtin_amdgcn_ballot_w64(lm - W.m[hh] > NSA_THR) != 0ull) {
                            const float mn = fmaxf(W.m[hh], max4(lm, hi)), alpha = __builtin_amdgcn_exp2f(W.m[hh] - mn);
                            W.l[hh] *= alpha; W.m[hh] = mn;
#pragma unroll
                            for (int et = 0; et < 4; ++et) W.o[hh][et] = W.o[hh][et] * alpha;
                        }
                        const float nm = -W.m[hh]; float ps = 0.f;
#pragma unroll
                        for (int sub = 0; sub < 2; ++sub)
#pragma unroll
                            for (int r = 0; r < 4; ++r) { s[sub][r] = __builtin_amdgcn_exp2f(s[sub][r] + nm); ps += s[sub][r]; }
                        W.l[hh] += ps;
                    }
                    const h16x8 pf = {(h16)s[0][0], (h16)s[0][1], (h16)s[0][2], (h16)s[0][3], (h16)s[1][0], (h16)s[1][1], (h16)s[1][2], (h16)s[1][3]};
#pragma unroll
                    for (int et = 0; et < 4; ++et) W.o[hh][et] = mfma16(vf[et], pf, W.o[hh][et]);
                }
            }
            if (MODE == 1) {
                const float up0 = __shfl(Llast[0], (lane - 16) & 63), up1 = __shfl(Llast[1], (lane - 16) & 63);
                const float own0 = Lloc[0] + (kq ? up0 : prev_carry), own1 = Lloc[1] + (kq ? up1 : up0);
                prev_carry = up1;
                impw[fr * 65 + 8 * kt + kq] = own0; impw[fr * 65 + 8 * kt + 4 + kq] = own1;
            }
        }
      }
        if (stg < stg_hi) NSA_STAGE_STORE(buf ^ 1, nk0, nv0);
        __syncthreads();
        buf ^= 1;
    }
#undef NSA_STAGE_LOAD
#undef NSA_STAGE_STORE
}

__device__ __forceinline__ void nsa_unit(const Params& p, int unit, LAS unsigned char* lds, int wv) {
    PHASE_IDS();
    const h16* H = (const h16*)(ws + WS_H); h16* MIX = (h16*)(ws + WS_MIX);
    const int ub = 31 - (unit >> 4), bg = unit & 15, g = bg & 1, b = bg >> 1;
    const int fr = lane & 15, kq = lane >> 4, hi = lane >> 5;
    const int t0 = 128 * ub, tw = t0 + 16 * wave, t = tw + fr, cur = tw >> 6;
    LAS float* BT = (LAS float*)(lds + NSL_BT); LAS float* impw = (LAS float*)(lds + NSL_IMP) + wave * (16 * 65);
    if (tid < 384) { const int hh = tid >> 7, d = tid & 127; int bk = d;
        if (d >= 16) bk = 16 + (d >= 19) + (d >= 21) + (d >= 24) + (d >= 27) + (d >= 31) + (d >= 35) + (d >= 40) + (d >= 46) + (d >= 52) + (d >= 59) + (d >= 67) + (d >= 77) + (d >= 87) + (d >= 99) + (d >= 113);
        BT[tid] = p.in[12][bk * 6 + g * 3 + hh] * 1.4426950408889634f; }
    for (int i = lane; i < 16 * 65; i += 64) impw[i] = 0.f;
    const size_t hrow = (size_t)(b * SEQ + t) * NH;
    NsaW W; { LAS h16x8* qw = (LAS h16x8*)(lds + NSL_Q) + wave * (6 * 64); W.qf = qw;
#pragma unroll
    for (int hh = 0; hh < 3; ++hh)
#pragma unroll
        for (int ks = 0; ks < 2; ++ks) { h16x8 q = *(const h16x8*)(H + hrow + C_NQ + (g * 3 + hh) * 64 + 32 * ks + 8 * kq); qw[(hh * 2 + ks) * 64 + lane] = q * (h16)(0.125f * 1.4426950408889634f); } }
#define NSA_GATE(hh, i) (1.f / (1.f + __expf(-(float)H[hrow + C_G + (g * 3 + (hh)) * 3 + (i)])))
#define NSA_ACC(hh, et, scale, FIRST, LAST) do { const int e_ = 16 * (et) + 4 * kq, hc_ = (g * 3 + (hh)) * 64 + e_; h16* dst_ = MIX + (size_t)(b * SEQ + t) * DM + hc_; \
        f32x4 a_ = W.o[hh][et] * (scale); \
        if (!(FIRST)) { const h16x4 d_ = *(const h16x4*)dst_; a_ = a_ + (f32x4){(float)d_[0], (float)d_[1], (float)d_[2], (float)d_[3]}; } \
        if (LAST) { const h16x4 zz_ = *(const h16x4*)(H + hrow + C_NZ + hc_); a_ = a_ * (f32x4){silu_f((float)zz_[0]), silu_f((float)zz_[1]), silu_f((float)zz_[2]), silu_f((float)zz_[3])}; } \
        *(h16x4*)dst_ = (h16x4){(h16)a_[0], (h16)a_[1], (h16)a_[2], (h16)a_[3]}; } while (0)
    __syncthreads();
    const h16* KC = (const h16*)(ws + WS_KC) + (size_t)bg * 256 * 64; const h16* VC = (const h16*)(ws + WS_VCT) + (size_t)bg * 256 * 64;
    const int ct_hi = (t0 + 127 - 16) / 512;
#pragma unroll
    for (int hh = 0; hh < 3; ++hh) { W.m[hh] = NSA_NEG; W.l[hh] = 0.f; }
    nsa_pass<0>(W, KC, VC, 64, 0, ct_hi, tw, t, 0ull, lds, BT, impw, tid, lane, wave);
#pragma unroll
    for (int hh = 0; hh < 3; ++hh) { const float mr = max4(W.m[hh], hi); const float lr = sum4(W.l[hh] * __builtin_amdgcn_exp2f(W.m[hh] - mr), hi); W.m[hh] = mr; W.l[hh] = lr > 0.f ? 1.f / lr : 0.f;
#pragma unroll
        for (int et = 0; et < 4; ++et) W.o[hh][et] = (f32x4){0.f, 0.f, 0.f, 0.f}; }
    nsa_pass<1>(W, KC, VC, 64, 0, ct_hi, tw, t, 0ull, lds, BT, impw, tid, lane, wave);
#pragma unroll
    for (int hh = 0; hh < 3; ++hh) { const float sc = NSA_GATE(hh, 0);
#pragma unroll
        for (int et = 0; et < 4; ++et) NSA_ACC(hh, et, sc, true, false); }
    asm volatile("s_waitcnt lgkmcnt(0)" ::: "memory");
    unsigned long long sel;
    if (cur <= 15) sel = (2ull << cur) - 1ull;
    else {
        float v[16];
#pragma unroll
        for (int i = 0; i < 16; ++i) { const int j = 4 * i + kq; v[i] = (j >= 1 && j <= cur - 2) ? impw[fr * 65 + j] : -1.f; }
        sel = 1ull | (3ull << (cur - 1));
        for (int round = 0; round < 13; ++round) {
            float bv = v[0]; int bj = kq;
#pragma unroll
            for (int i = 1; i < 16; ++i) if (v[i] > bv) { bv = v[i]; bj = 4 * i + kq; }
            { const float ov = __shfl_xor(bv, 16); const int oj = __shfl_xor(bj, 16); if (ov > bv || (ov == bv && oj < bj)) { bv = ov; bj = oj; } }
            { const float ov = __shfl_xor(bv, 32); const int oj = __shfl_xor(bj, 32); if (ov > bv || (ov == bv && oj < bj)) { bv = ov; bj = oj; } }
            sel |= 1ull << bj;
#pragma unroll
            for (int i = 0; i < 16; ++i) v[i] = (4 * i + kq == bj) ? -1.f : v[i];
        }
    }
    const h16* Hb = H + (size_t)b * SEQ * NH;
    for (int rep = 0; rep < REP_SEL; ++rep) {
#pragma unroll
    for (int hh = 0; hh < 3; ++hh) { W.m[hh] = NSA_MINIT; W.l[hh] = 0.f;
#pragma unroll
        for (int et = 0; et < 4; ++et) W.o[hh][et] = (f32x4){0.f, 0.f, 0.f, 0.f}; }
    nsa_pass<2>(W, Hb + C_KS + g * 64, Hb + C_VS + g * 64, NH, 0, (t0 + 127) >> 5, tw, t, sel, lds, BT, impw, tid, lane, wave);
    }
#pragma unroll
    for (int hh = 0; hh < 3; ++hh) { const float lr = sum4(W.l[hh], hi); const float sc = lr > 0.f ? NSA_GATE(hh, 1) / lr : 0.f;
#pragma unroll
        for (int et = 0; et < 4; ++et) NSA_ACC(hh, et, sc, false, false); }
    for (int rep = 0; rep < REP_WIN; ++rep) {
#pragma unroll
    for (int hh = 0; hh < 3; ++hh) { W.m[hh] = NSA_MINIT; W.l[hh] = 0.f;
#pragma unroll
        for (int et = 0; et < 4; ++et) W.o[hh][et] = (f32x4){0.f, 0.f, 0.f, 0.f}; }
    nsa_pass<3>(W, Hb + C_KW + g * 64, Hb + C_VW + g * 64, NH, (t0 - 511 < 0) ? 0 : (t0 - 511) >> 5, (t0 + 127) >> 5, tw, t, 0ull, lds, BT, impw, tid, lane, wave);
    }
#pragma unroll
    for (int hh = 0; hh < 3; ++hh) { const float lr = sum4(W.l[hh], hi); const float sc = lr > 0.f ? NSA_GATE(hh, 2) / lr : 0.f;
#pragma unroll
        for (int et = 0; et < 4; ++et) NSA_ACC(hh, et, sc, false, true); }
    __syncthreads();
}

#define LDS_WAIT() asm volatile("s_waitcnt lgkmcnt(0)" ::: "memory")
__device__ __forceinline__ void tr_item(const float* W, int ldw, int srccol0, h16* WT, int K, int dstrow0, int k0, LAS float* scr, int lane) {
#pragma unroll 8
    for (int i = 0; i < 32; ++i) { const int kk = 2 * i + (lane >> 5); scr[kk * 33 + (lane & 31)] = srccol0 >= 0 ? W[(size_t)(k0 + kk) * ldw + srccol0 + (lane & 31)] : 0.f; }
    LDS_WAIT(); asm volatile("" ::: "memory");
    const int c = lane & 7;
#pragma unroll
    for (int j = 0; j < 4; ++j) { const int n = (lane >> 3) + 8 * j; const LAS float* s = scr + (8 * c) * 33 + n;
        u32x4 o; o.x = pk2h(s[0 * 33], s[1 * 33]); o.y = pk2h(s[2 * 33], s[3 * 33]); o.z = pk2h(s[4 * 33], s[5 * 33]); o.w = pk2h(s[6 * 33], s[7 * 33]);
        *(u32x4*)(WT + (size_t)(dstrow0 + n) * K + k0 + 8 * c) = o; }
    LDS_WAIT(); asm volatile("" ::: "memory");
}

__device__ __forceinline__ void prologue(const Params& p, LAS unsigned char* lds, int wv) {
    PHASE_IDS();
    LAS float* scr = (LAS float*)(lds + wave * 16384);
    const int gw = blockIdx.x * 8 + wave, NGW = gridDim.x * 8;
    constexpr int I_IN = 16 * (NH / 32), I_OUT = 16 * 32, I_C1 = 32 * 4, I_C2 = 2 * 2;
    constexpr int N_IN = 2 * I_IN, N_OUT = 2 * I_OUT, N_C1 = 4 * I_C1, N_C2 = 4 * I_C2, N_PB = 128;
    constexpr int NITEMS = N_IN + N_OUT + N_C1 + N_C2 + N_PB;
    for (int it = gw; it < NITEMS; it += NGW) {
        int r = it;
        if (r < N_IN) { const int l = r / I_IN, q = r % I_IN, kb = q / (NH / 32), nb = q % (NH / 32), n0 = 32 * nb;
            const int src = n0 < 1152 ? n0 : (n0 < 4096 ? n0 + 18 : (n0 == 4096 ? 1152 : -1));
            tr_item(p.in[1] + (size_t)l * 1024 * DIN, DIN, src, (h16*)(ws + WS_WINT) + (size_t)l * NH * 1024, 1024, n0, 64 * kb, scr, lane); continue; }
        r -= N_IN;
        if (r < N_OUT) { const int l = r / I_OUT, q = r % I_OUT, kb = q / 32, nb = q % 32;
            tr_item(p.in[9] + (size_t)l * 1024 * 1024, 1024, 32 * nb, (h16*)(ws + WS_WOUTT) + (size_t)l * 1024 * 1024, 1024, 32 * nb, 64 * kb, scr, lane); continue; }
        r -= N_OUT;
        if (r < N_C1) { const int lk = r / I_C1, l = lk >> 1, kv = lk & 1, q = r % I_C1, kb = q / 4, nb = q % 4;
            tr_item((kv ? p.in[5] : p.in[3]) + (size_t)l * 2048 * 128, 128, 32 * nb, (h16*)(ws + WS_WC1T) + (size_t)lk * 128 * 2048, 2048, 32 * nb, 64 * kb, scr, lane); continue; }
        r -= N_C1;
        if (r < N_C2) { const int lk = r / I_C2, l = lk >> 1, kv = lk & 1, q = r % I_C2, kb = q / 2, nb = q % 2;
            tr_item((kv ? p.in[6] : p.in[4]) + (size_t)l * 128 * 64, 64, 32 * nb, (h16*)(ws + WS_WC2T) + (size_t)lk * 64 * 128, 128, 32 * nb, 64 * kb, scr, lane); continue; }
        r -= N_C2;
        {
            const int lk = r >> 5, l = lk >> 1, kv = lk & 1, c = r & 31;
            const float* w1 = (kv ? p.in[5] : p.in[3]) + (size_t)l * 2048 * 128; const float* pos = p.in[2] + (size_t)l * 2048;
            float a0 = 0.f, a1 = 0.f;
#pragma unroll 8
            for (int ii = 0; ii < 64; ++ii) { const int i = c * 64 + ii; const float pv = pos[i]; a0 += pv * w1[(size_t)i * 128 + lane]; a1 += pv * w1[(size_t)i * 128 + 64 + lane]; }
            float* o = (float*)(ws + WS_PBP) + ((size_t)lk * 32 + c) * 128; o[lane] = a0; o[64 + lane] = a1;
        }
    }
    const float* x = p.in[0]; h16* xh = (h16*)(ws + WS_XH);
    const size_t nvec = (size_t)MTOK * DM / 8;
    for (size_t i = (size_t)blockIdx.x * 512 + tid; i < nvec; i += (size_t)gridDim.x * 512) {
        const f32x4 a = *(const f32x4*)(x + i * 8), b = *(const f32x4*)(x + i * 8 + 4);
        u32x4 o; o.x = pk2h(a[0], a[1]); o.y = pk2h(a[2], a[3]); o.z = pk2h(b[0], b[1]); o.w = pk2h(b[2], b[3]);
        *(u32x4*)(xh + i * 8) = o;
    }
}

__device__ __forceinline__ void ln_phase(const Params& p, int layer, int wv) {
    PHASE_IDS();
    const float* Y = (const float*)(ws + WS_H); const float* g = p.in[10] + (size_t)layer * DM; const float* bb = p.in[11] + (size_t)layer * DM; float* xout = p.out; h16* xh = (h16*)(ws + WS_XH);
    const int gw = blockIdx.x * 8 + wave, NGW = gridDim.x * 8;
    f32x4 gv[4], bv[4];
#pragma unroll
    for (int j = 0; j < 4; ++j) { gv[j] = *((const f32x4*)g + lane + 64 * j); bv[j] = *((const f32x4*)bb + lane + 64 * j); }
    for (int m = gw; m < MTOK; m += NGW) {
        const f32x4* yr = (const f32x4*)(Y + (size_t)m * DM) + lane;
        f32x4 v[4]; float s = 0.f;
#pragma unroll
        for (int j = 0; j < 4; ++j) { v[j] = yr[64 * j]; s += (v[j][0] + v[j][1]) + (v[j][2] + v[j][3]); }
        const float mean = wave_sum(s) * (1.f / DM); float s2 = 0.f;
#pragma unroll
        for (int j = 0; j < 4; ++j) { v[j] = v[j] - mean; s2 += (v[j][0] * v[j][0] + v[j][1] * v[j][1]) + (v[j][2] * v[j][2] + v[j][3] * v[j][3]); }
        const float rstd = 1.f / sqrtf(wave_sum(s2) * (1.f / DM) + 1e-5f);
        f32x4* orow = (f32x4*)(xout + (size_t)m * DM) + lane; u32x2* hrow = (u32x2*)(xh + (size_t)m * DM) + lane;
#pragma unroll
        for (int j = 0; j < 4; ++j) { const f32x4 o = v[j] * rstd * gv[j] + bv[j]; orow[64 * j] = o; u32x2 w; w.x = pk2h(o[0], o[1]); w.y = pk2h(o[2], o[3]); hrow[64 * j] = w; }
    }
}

__device__ __forceinline__ float gelu_tanh(float x) {
    const float y = 0.7978845608028654f * (x + 0.044715f * x * x * x);
    const float t = 1.f - 2.f / (1.f + __expf(2.f * y));
    return 0.5f * x * (1.f + t);
}
__device__ __forceinline__ void compress_unit(const Params& p, int layer, int cu, LAS unsigned char* lds, int wv) {
    PHASE_IDS();
    const int nt = cu & 7, kv = (cu >> 3) & 1, g = (cu >> 4) & 1, b = cu >> 5, lk = layer * 2 + kv;
    const h16* H = (const h16*)(ws + WS_H);
    const h16* W1T = (const h16*)(ws + WS_WC1T) + (size_t)lk * 128 * 2048;
    const h16* W2T = (const h16*)(ws + WS_WC2T) + (size_t)lk * 64 * 128;
    const float* PBP = (const float*)(ws + WS_PBP) + (size_t)lk * 32 * 128;
    LAS h16* hid = (LAS h16*)lds;
    const int fr = lane & 15, kq = lane >> 4;
    const int colbase = (kv ? C_VC : C_KC) + g * 64;
    const int j0 = 16 * wave;
    f32x4 acc[2] = {{0.f, 0.f, 0.f, 0.f}, {0.f, 0.f, 0.f, 0.f}};
    const h16* bptr = W1T + (size_t)(j0 + fr) * 2048 + 8 * kq;
    const int n_a0 = 32 * nt + fr, n_a1 = n_a0 + 16;
#pragma unroll 4
    for (int ks = 0; ks < 64; ++ks) {
        const int pp = ks >> 1, dd = 32 * (ks & 1) + 8 * kq;
        int tok0 = 16 * n_a0 + pp; tok0 = tok0 > SEQ - 1 ? SEQ - 1 : tok0;
        int tok1 = 16 * n_a1 + pp; tok1 = tok1 > SEQ - 1 ? SEQ - 1 : tok1;
        const h16x8 a0 = *(const h16x8*)(H + (size_t)(b * SEQ + tok0) * NH + colbase + dd);
        const h16x8 a1 = *(const h16x8*)(H + (size_t)(b * SEQ + tok1) * NH + colbase + dd);
        const h16x8 bf = *(const h16x8*)(bptr + 32 * ks);
        acc[0] = mfma16(a0, bf, acc[0]); acc[1] = mfma16(a1, bf, acc[1]);
    }
    float bias = 0.f;
#pragma unroll 8
    for (int c = 0; c < 32; ++c) bias += PBP[c * 128 + j0 + fr];
#pragma unroll
    for (int rt = 0; rt < 2; ++rt)
#pragma unroll
        for (int r = 0; r < 4; ++r) hid[(16 * rt + 4 * kq + r) * 136 + j0 + fr] = (h16)gelu_tanh(acc[rt][r] + bias);
    __syncthreads();
    {
        const int rt = wave >> 2, dt = wave & 3;
        f32x4 o = {0.f, 0.f, 0.f, 0.f};
#pragma unroll
        for (int ks = 0; ks < 4; ++ks) {
            const h16x8 a = *(const LAS h16x8*)(hid + (16 * rt + fr) * 136 + 32 * ks + 8 * kq);
            const h16x8 bf = *(const h16x8*)(W2T + (size_t)(16 * dt + fr) * 128 + 32 * ks + 8 * kq);
            o = mfma16(a, bf, o);
        }
        const int d = 16 * dt + fr, n0 = 32 * nt + 16 * rt + 4 * kq;
        if (kv == 0) { h16* KC = (h16*)(ws + WS_KC) + (size_t)(b * 2 + g) * 256 * 64;
#pragma unroll
            for (int r = 0; r < 4; ++r) KC[(size_t)(n0 + r) * 64 + d] = (h16)o[r]; }
        else { h16* VC = (h16*)(ws + WS_VCT) + (size_t)(b * 2 + g) * 256 * 64;
#pragma unroll
            for (int r = 0; r < 4; ++r) VC[(size_t)(n0 + r) * 64 + d] = (h16)o[r]; }
    }
    __syncthreads();
}

constexpr int HGL_QS = 0, HGL_KS = 17408, HGL_BS = 34816, HGL_QT = 52224, HGL_VT = 61440, HGL_ST = 70656, HGL_AT = 79872, HGL_OS = 89088, HGL_TOT = 105728;
__device__ __forceinline__ void hg_prep(const h16* H, int r0, int hd, float lbv, int d, int seg, LAS float* tot, float (&bv)[8], float (&kv)[8], float& blast) {
    float cs = 0.f; const float lbf = fmaxf(lbv, 1e-30f), oml = 1.f - lbv;
#pragma unroll
    for (int i = 0; i < 8; ++i) {
        const float f = (float)H[(size_t)(r0 + 8 * seg + i) * NH + C_HF + hd * 64 + d];
        const float e = __expf(-fabsf(f)), r = 1.f / (1.f + e);
        const float sig = f >= 0.f ? r : e * r, sigm = f >= 0.f ? e * r : r;
        cs += __logf(lbf + oml * sig); bv[i] = cs; kv[i] = oml * sigm;
    }
    tot[seg * 64 + d] = cs;
    __syncthreads();
    float off = 0.f, all = 0.f;
#pragma unroll
    for (int s = 0; s < 8; ++s) { const float v = tot[s * 64 + d]; all += v; off += s < seg ? v : 0.f; }
#pragma unroll
    for (int i = 0; i < 8; ++i) bv[i] += off;
    blast = all;
}
__device__ __forceinline__ float hg_lb(const Params& p, int layer, int idx) {
    if (layer == 0) return 0.f;
    const float a0 = p.in[7][idx], a1 = p.in[7][384 + idx];
    return 1.f / (1.f + __expf(a0 - a1));
}
__device__ __forceinline__ void hg_state_unit(const Params& p, int layer, int u, LAS unsigned char* lds, int wv) {
    PHASE_IDS();
    const h16* H = (const h16*)(ws + WS_H);
    float* HGU = (float*)(ws + WS_HGU); float* HGD = (float*)(ws + WS_HGD);
    const int c = u & 63, bh = u >> 6, hd = bh % 6, b = bh / 6, r0 = b * SEQ + 64 * c;
    const int d = tid & 63, seg = tid >> 6;
    LAS h16* KT = (LAS h16*)(lds + HGL_QT); LAS h16* VT = (LAS h16*)(lds + HGL_VT); LAS float* tot = (LAS float*)(lds + HGL_TOT);
    float bv[8], kv[8], blast;
    hg_prep(H, r0, hd, hg_lb(p, layer, hd * 64 + d), d, seg, tot, bv, kv, blast);
    h16x8 kt, vt;
#pragma unroll
    for (int i = 0; i < 8; ++i) { kt[i] = (h16)(kv[i] * __expf(blast - bv[i])); vt[i] = H[(size_t)(r0 + 8 * seg + i) * NH + C_HI + hd * 64 + d]; }
    *(LAS h16x8*)(KT + d * 72 + 8 * seg) = kt; *(LAS h16x8*)(VT + d * 72 + 8 * seg) = vt;
    if (seg == 0) HGD[(size_t)u * 64 + d] = __expf(blast);
    __syncthreads();
    if (wave < 4) {
        const int et = wave >> 1, dt = wave & 1, r32 = lane & 31, hi = lane >> 5;
        f32x16 acc = {};
#pragma unroll
        for (int ks = 0; ks < 4; ++ks) {
            const h16x8 a = *(const LAS h16x8*)(VT + (32 * et + r32) * 72 + 16 * ks + 8 * hi);
            const h16x8 bf = *(const LAS h16x8*)(KT + (32 * dt + r32) * 72 + 16 * ks + 8 * hi);
            acc = mfma32(a, bf, acc);
        }
#pragma unroll
        for (int r = 0; r < 16; ++r) HGU[((size_t)u * 64 + 32 * et + crow(r, hi)) * 64 + 32 * dt + r32] = acc[r];
    }
    __syncthreads();
}
constexpr int HG2_QH = 0, HG2_KH = 9216, HG2_QD = 18432, HG2_KD = 35840, HG2_VT = 53248, HG2_ST = 62464, HG2_OS = 71680, HG2_TOT = 88320, HG2_G = 90368, HG2_E = 90880;
__device__ __forceinline__ void hg_out_unit(const Params& p, int layer, int unit, LAS unsigned char* lds, int wv) {
    PHASE_IDS();
    const h16* H = (const h16*)(ws + WS_H); h16* MIX = (h16*)(ws + WS_MIX);
    const float* HGU = (const float*)(ws + WS_HGU); const float* HGD = (const float*)(ws + WS_HGD);
    constexpr int NG = NCHUNK / HG_G;
    const int gi = unit % NG, bh = unit / NG, hd = bh % 6, b = bh / 6, c0 = gi * HG_G;
    const int d = tid & 63, seg = tid >> 6, e_own = tid >> 3, d0 = (tid & 7) * 8, I_own = seg >> 1;
    LAS h16* QH = (LAS h16*)(lds + HG2_QH); LAS h16* KH = (LAS h16*)(lds + HG2_KH); LAS float* QD = (LAS float*)(lds + HG2_QD); LAS float* KD = (LAS float*)(lds + HG2_KD);
    LAS h16* VT = (LAS h16*)(lds + HG2_VT); LAS h16* ST = (LAS h16*)(lds + HG2_ST); LAS float* OS = (LAS float*)(lds + HG2_OS); LAS float* tot = (LAS float*)(lds + HG2_TOT);
    LAS h16* GT = (LAS h16*)(lds + HG2_G); LAS h16* ET = (LAS h16*)(lds + HG2_E);
    const float lbv = hg_lb(p, layer, hd * 64 + d), lbf = fmaxf(lbv, 1e-30f), oml = 1.f - lbv;
    const float* nw = p.in[8] + (size_t)layer * 384 + hd * 64;
    float S[8];
#pragma unroll
    for (int j = 0; j < 8; ++j) S[j] = 0.f;
#pragma unroll 4
    for (int cc = 0; cc < c0; ++cc) {
        const size_t uu = (size_t)bh * 64 + cc;
        const f32x4 D0 = *(const f32x4*)(HGD + uu * 64 + d0), D1 = *(const f32x4*)(HGD + uu * 64 + d0 + 4);
        const f32x4 U0 = *(const f32x4*)(HGU + (uu * 64 + e_own) * 64 + d0), U1 = *(const f32x4*)(HGU + (uu * 64 + e_own) * 64 + d0 + 4);
#pragma unroll
        for (int j = 0; j < 4; ++j) { S[j] = D0[j] * S[j] + U0[j]; S[4 + j] = D1[j] * S[4 + j] + U1[j]; }
    }
    h16 fr_[8], qr_[8], vr_[8];
#define HG_LOAD_RAW(c_) do { const size_t base_ = (size_t)(b * SEQ + 64 * (c_) + 8 * seg) * NH + hd * 64 + d; \
        _Pragma("unroll") for (int i = 0; i < 8; ++i) { fr_[i] = H[base_ + (size_t)i * NH + C_HF]; qr_[i] = H[base_ + (size_t)i * NH + C_HQ]; vr_[i] = H[base_ + (size_t)i * NH + C_HI]; } } while (0)
    HG_LOAD_RAW(c0);
    for (int c = c0; c < c0 + HG_G; ++c) {
        const int r0 = b * SEQ + 64 * c; const size_t uu = (size_t)bh * 64 + c;
        const f32x4 D0 = *(const f32x4*)(HGD + uu * 64 + d0), D1 = *(const f32x4*)(HGD + uu * 64 + d0 + 4);
        const f32x4 U0 = *(const f32x4*)(HGU + (uu * 64 + e_own) * 64 + d0), U1 = *(const f32x4*)(HGU + (uu * 64 + e_own) * 64 + d0 + 4);
        const h16x8 zg = *(const h16x8*)(H + (size_t)(r0 + (tid >> 3)) * NH + C_HZ + hd * 64 + (tid & 7) * 8);
        float bl[8], ky[8], qv[8]; float cs = 0.f;
#pragma unroll
        for (int i = 0; i < 8; ++i) {
            const float f = (float)fr_[i]; const float e = __expf(-fabsf(f)), r = 1.f / (1.f + e);
            const float sig = f >= 0.f ? r : e * r, sigm = f >= 0.f ? e * r : r;
            cs += __logf(lbf + oml * sig); bl[i] = cs; ky[i] = oml * sigm; qv[i] = (float)qr_[i];
        }
        tot[seg * 64 + d] = cs;
        { h16x8 vt;
#pragma unroll
          for (int i = 0; i < 8; ++i) vt[i] = vr_[i];
          *(LAS h16x8*)(VT + d * 72 + 8 * seg) = vt; }
        { h16x8 st;
#pragma unroll
          for (int j = 0; j < 8; ++j) st[j] = (h16)S[j];
          *(LAS h16x8*)(ST + e_own * 72 + d0) = st; }
        __syncthreads();
        float P[9]; P[0] = 0.f;
#pragma unroll
        for (int s2 = 0; s2 < 8; ++s2) P[s2 + 1] = P[s2] + tot[s2 * 64 + d];
        float pre = 0.f, beta = 0.f, betan = 0.f, mu = 0.f;
#pragma unroll
        for (int s2 = 0; s2 < 9; ++s2) { pre = (s2 == seg) ? P[s2] : pre; beta = (s2 == 2 * I_own) ? P[s2] : beta; betan = (s2 == 2 * I_own + 2) ? P[s2] : betan; mu = (s2 == 2 * I_own + 1) ? P[s2] : mu; }
#pragma unroll
        for (int i = 0; i < 8; ++i) {
            const int t = 8 * seg + i; const float bb = pre + bl[i];
            QH[t * 72 + d] = (h16)(qv[i] * __expf(bb - beta)); KH[t * 72 + d] = (h16)(ky[i] * __expf(betan - bb));
            QD[t * 68 + d] = qv[i] * __expf(bb - mu); KD[t * 68 + d] = ky[i] * __expf(mu - bb);
        }
        if (seg == 0) {
            GT[0 * 64 + d] = (h16)__expf(P[4] - P[2]); GT[1 * 64 + d] = (h16)__expf(P[6] - P[4]); GT[2 * 64 + d] = (h16)__expf(P[6] - P[2]);
            ET[0 * 64 + d] = (h16)1.f; ET[1 * 64 + d] = (h16)__expf(P[2]); ET[2 * 64 + d] = (h16)__expf(P[4]); ET[3 * 64 + d] = (h16)__expf(P[6]);
        }
        if (c + 1 < c0 + HG_G) HG_LOAD_RAW(c + 1);
        __syncthreads();
        {
            const int I = wave & 3, eh = wave >> 2, fr = lane & 15, kq = lane >> 4, trow = 16 * I + fr;
            h16x8 qh[2];
#pragma unroll
            for (int ks = 0; ks < 2; ++ks) qh[ks] = *(const LAS h16x8*)(QH + trow * 72 + 32 * ks + 8 * kq);
            f32x4 att[4];
#pragma unroll
            for (int J = 0; J < 4; ++J) att[J] = (f32x4){0.f, 0.f, 0.f, 0.f};
            {
                f32x4 ad = {0.f, 0.f, 0.f, 0.f};
#pragma unroll
                for (int q4 = 0; q4 < 4; ++q4) {
                    const f32x4 ka = *(const LAS f32x4*)(KD + trow * 68 + 16 * kq + 4 * q4), qa = *(const LAS f32x4*)(QD + trow * 68 + 16 * kq + 4 * q4);
#pragma unroll
                    for (int x = 0; x < 4; ++x) ad = __builtin_amdgcn_mfma_f32_16x16x4f32(ka[x], qa[x], ad, 0, 0, 0);
                }
#pragma unroll
                for (int r = 0; r < 4; ++r) ad[r] = (4 * kq + r <= fr) ? ad[r] : 0.f;
#pragma unroll
                for (int J = 0; J < 4; ++J) att[J] = (J == I) ? ad : att[J];
            }
#pragma unroll
            for (int J = 0; J < 3; ++J) {
                if (J < I) {
                    h16x8 kh0 = *(const LAS h16x8*)(KH + (16 * J + fr) * 72 + 8 * kq), kh1 = *(const LAS h16x8*)(KH + (16 * J + fr) * 72 + 32 + 8 * kq);
                    if (I - J >= 2) { const int gi2 = (I == 2) ? 0 : (J == 1 ? 1 : 2);
                        kh0 = kh0 * *(const LAS h16x8*)(GT + gi2 * 64 + 8 * kq); kh1 = kh1 * *(const LAS h16x8*)(GT + gi2 * 64 + 32 + 8 * kq); }
                    f32x4 a = {0.f, 0.f, 0.f, 0.f};
                    a = mfma16(kh0, qh[0], a); a = mfma16(kh1, qh[1], a);
                    att[J] = a;
                }
            }
            const h16x8 pf01 = {(h16)att[0][0], (h16)att[0][1], (h16)att[0][2], (h16)att[0][3], (h16)att[1][0], (h16)att[1][1], (h16)att[1][2], (h16)att[1][3]};
            const h16x8 pf23 = {(h16)att[2][0], (h16)att[2][1], (h16)att[2][2], (h16)att[2][3], (h16)att[3][0], (h16)att[3][1], (h16)att[3][2], (h16)att[3][3]};
            const h16x8 qe0 = qh[0] * *(const LAS h16x8*)(ET + I * 64 + 8 * kq), qe1 = qh[1] * *(const LAS h16x8*)(ET + I * 64 + 32 + 8 * kq);
#pragma unroll
            for (int e2 = 0; e2 < 2; ++e2) {
                const int et = 2 * eh + e2, erow = 16 * et + fr;
                f32x4 o = {0.f, 0.f, 0.f, 0.f};
                { const h16x4 v0 = *(const LAS h16x4*)(VT + erow * 72 + 4 * kq), v1 = *(const LAS h16x4*)(VT + erow * 72 + 16 + 4 * kq);
                  o = mfma16((h16x8){v0[0], v0[1], v0[2], v0[3], v1[0], v1[1], v1[2], v1[3]}, pf01, o); }
                if (I >= 2) { const h16x4 v0 = *(const LAS h16x4*)(VT + erow * 72 + 32 + 4 * kq), v1 = *(const LAS h16x4*)(VT + erow * 72 + 48 + 4 * kq);
                  o = mfma16((h16x8){v0[0], v0[1], v0[2], v0[3], v1[0], v1[1], v1[2], v1[3]}, pf23, o); }
                o = mfma16(*(const LAS h16x8*)(ST + erow * 72 + 8 * kq), qe0, o);
                o = mfma16(*(const LAS h16x8*)(ST + erow * 72 + 32 + 8 * kq), qe1, o);
#pragma unroll
                for (int r = 0; r < 4; ++r) OS[trow * 65 + 16 * et + 4 * kq + r] = o[r];
            }
        }
#pragma unroll
        for (int j = 0; j < 4; ++j) { S[j] = D0[j] * S[j] + U0[j]; S[4 + j] = D1[j] * S[4 + j] + U1[j]; }
        __syncthreads();
        {
            const int t = tid >> 3, e0 = (tid & 7) * 8;
            float o[8], ssq = 0.f;
#pragma unroll
            for (int j = 0; j < 8; ++j) { o[j] = OS[t * 65 + e0 + j]; ssq += o[j] * o[j]; }
            ssq += __shfl_xor(ssq, 1); ssq += __shfl_xor(ssq, 2); ssq += __shfl_xor(ssq, 4);
            const float rinv = 1.f / sqrtf(ssq * (1.f / 64.f) + 1e-6f);
            const f32x4 w0 = *(const f32x4*)(nw + e0), w1 = *(const f32x4*)(nw + e0 + 4);
            h16x8 ov;
#pragma unroll
            for (int j = 0; j < 8; ++j) { const float zz = (float)zg[j]; const float w = j < 4 ? w0[j & 3] : w1[j & 3];
                ov[j] = (h16)(o[j] * rinv * w * (zz / (1.f + __expf(-zz)))); }
            *(h16x8*)(MIX + (size_t)(r0 + t) * DM + 640 + hd * 64 + e0) = ov;
        }
    }
#undef HG_LOAD_RAW
    __syncthreads();
}

constexpr int REP_P0 = 1, REP_P1 = 1, REP_P4 = 1, REP_P5 = 1, REP_P2 = 1, REP_NSA = 1, REP_SB = 1, REP_HG = 1;
constexpr int LDS_BYTES = 147456;
__global__ void __launch_bounds__(512, 2) mega(Params p) {
    extern __shared__ __attribute__((aligned(16))) unsigned char lds_raw[];
    LAS unsigned char* lds = (LAS unsigned char*)lds_raw;
    cg::grid_group grid = cg::this_grid();
    const int wv = __builtin_amdgcn_readfirstlane(threadIdx.x >> 6);
    { LAS unsigned* misc = (LAS unsigned*)(lds + LDS_BYTES - 64); if (threadIdx.x < 16) misc[threadIdx.x] = 0u; }
    __syncthreads();
    XcdBarrier xbar = xcd_barrier_post((unsigned*)(p.ws + WS_CTL), (volatile LAS unsigned*)(lds + LDS_BYTES - 64));
#define GRID_BAR() xcd_barrier(xbar, wv)

    for (int rep = 0; rep < REP_P0; ++rep) prologue(p, lds, wv);
    grid.sync();
    for (int layer = 0; layer < DEPTH; ++layer) {
        {
            unsigned char* ws = p.ws; asm volatile("" : "+s"(ws)); h16* XH = (h16*)(ws + WS_XH); h16* Hb = (h16*)(ws + WS_H);
            pg8::Gemm g{(const pg8::bf16_t*)XH, (const pg8::bf16_t*)((h16*)(ws + WS_WINT) + (size_t)layer * NH * 1024), MTOK, NH, DM};
            pg8::StaticOrder S; S.init(MTOK, NH, gridDim.x, blockIdx.x);
            pg8::EpiH E{Hb, NH};
            for (int rep = 0; rep < REP_P1; ++rep) pg8::gemm_phase<pg8::EpiH, pg8::StaticOrder, true, true>(lds, g, S, E, wv);
        }
        GRID_BAR();
        for (int rep = 0; rep < REP_P2; ++rep)
        for (int u = blockIdx.x; u < 256 + 3072; u += gridDim.x) {
            if (u < 256) compress_unit(p, layer, u, lds, wv);
            else hg_state_unit(p, layer, u - 256, lds, wv);
        }
        GRID_BAR();
        {
            constexpr int N_HG = 48 * (NCHUNK / HG_G), N_UNITS = 512 + N_HG + 512;
            unsigned* ctr = (unsigned*)(p.ws + WS_CTL + 32768) + 64 * layer;
            LAS int* qslot = (LAS int*)(lds + LDS_BYTES - 128);
            for (;;) {
                if (wv == 0 && __builtin_amdgcn_mbcnt_hi(~0u, __builtin_amdgcn_mbcnt_lo(~0u, 0u)) == 0) qslot[0] = (int)__hip_atomic_fetch_add(ctr, 1u, __ATOMIC_RELAXED, __HIP_MEMORY_SCOPE_AGENT);
                __syncthreads();
                const int u = qslot[0];
                __syncthreads();
                if (u >= N_UNITS) break;
                if (u < 512) { for (int rep = 0; rep < REP_NSA; ++rep) nsa_unit(p, u, lds, wv); }
                else if (u < 512 + N_HG) { for (int rep = 0; rep < REP_HG; ++rep) hg_out_unit(p, layer, u - 512, lds, wv); }
                else { for (int rep = 0; rep < REP_SB; ++rep) sb_unit(p, u - 512 - N_HG, lds, wv); }
            }
        }
        GRID_BAR();
        {
            unsigned char* ws = p.ws; asm volatile("" : "+s"(ws)); h16* MIX = (h16*)(ws + WS_MIX); float* Y = (float*)(ws + WS_H);
            pg8::Gemm g{(const pg8::bf16_t*)MIX, (const pg8::bf16_t*)((h16*)(ws + WS_WOUTT) + (size_t)layer * 1024 * 1024), MTOK, DM, DM};
            pg8::StaticOrder S; S.init(MTOK, DM, gridDim.x, blockIdx.x);
            pg8::EpiY E{layer == 0 ? p.in[0] : p.out, Y, ALPHA};
            for (int rep = 0; rep < REP_P4; ++rep) pg8::gemm_phase<pg8::EpiY, pg8::StaticOrder, true, true>(lds, g, S, E, wv);
        }
        GRID_BAR();
        for (int rep = 0; rep < REP_P5; ++rep) ln_phase(p, layer, wv);
        if (layer + 1 < DEPTH) GRID_BAR();
    }
}

extern "C" void kernel_launch(void* const* d_in, const int* in_sizes, int n_in, void* d_out, int out_size, void* d_ws, size_t ws_size, hipStream_t stream) {
    static int grid = 0;
    if (grid == 0) {
        if (n_in != 13 || ws_size < WS_END) { fprintf(stderr, "kernel_launch: unexpected n_in %d or ws_size %zu (< %zu)\n", n_in, ws_size, (size_t)WS_END); grid = -1; return; }
        int dev = 0, cus = 0, per_cu = 0;
        hipGetDevice(&dev); hipDeviceGetAttribute(&cus, hipDeviceAttributeMultiprocessorCount, dev);
        if (hipFuncSetAttribute((const void*)mega, hipFuncAttributeMaxDynamicSharedMemorySize, LDS_BYTES) != hipSuccess) { fprintf(stderr, "kernel_launch: hipFuncSetAttribute failed\n"); grid = -1; return; }
        if (hipOccupancyMaxActiveBlocksPerMultiprocessor(&per_cu, (const void*)mega, 512, LDS_BYTES) != hipSuccess || per_cu < 1) { fprintf(stderr, "kernel_launch: occupancy query failed (%d)\n", per_cu); (void)hipGetLastError(); per_cu = 1; }
        grid = cus * per_cu;
        fprintf(stderr, "kernel_launch: cus %d per_cu %d grid %d\n", cus, per_cu, grid);
    }
    if (grid < 0) return;
    hipMemsetAsync((char*)d_ws + WS_CTL, 0, CTL_BYTES, stream);
    Params p{};
    for (int i = 0; i < 13; ++i) p.in[i] = (const float*)d_in[i];
    p.out = (float*)d_out; p.ws = (unsigned char*)d_ws;
    void* args[] = {&p};
    hipError_t e = hipLaunchCooperativeKernel((const void*)mega, dim3(grid), dim3(512), args, LDS_BYTES, stream);
    if (e != hipSuccess) fprintf(stderr, "cooperative launch failed: %s (grid %d)\n", hipGetErrorString(e), grid);
}
```

```cpp
#include <hip/hip_runtime.h>
#include <hip/hip_cooperative_groups.h>
#include <cstdio>
#include <cstdint>
namespace cg = cooperative_groups;

#define LAS __attribute__((address_space(3)))
typedef _Float16 h16;
typedef _Float16 h16x8 __attribute__((ext_vector_type(8)));
typedef _Float16 h16x4 __attribute__((ext_vector_type(4)));
typedef _Float16 h16x2 __attribute__((ext_vector_type(2)));
typedef short s16x4 __attribute__((ext_vector_type(4)));
typedef float f32x2 __attribute__((ext_vector_type(2)));
typedef float f32x4 __attribute__((ext_vector_type(4)));
typedef unsigned u32x4 __attribute__((ext_vector_type(4)));
typedef float f32x16 __attribute__((ext_vector_type(16)));
typedef unsigned u32x2 __attribute__((ext_vector_type(2)));

constexpr int NB = 8, SEQ = 4096, DM = 1024, MTOK = NB * SEQ, DEPTH = 2;
constexpr int DIN = 4114, NH = 4352;
constexpr int C_NQ = 0, C_KC = 384, C_VC = 512, C_KS = 640, C_VS = 768, C_KW = 896, C_VW = 1024, C_NZ = 1152;
constexpr int C_SQ = 1536, C_SK = 1792, C_SV = 2048, C_SZ = 2304, C_HQ = 2560, C_HF = 2944, C_HI = 3328, C_HZ = 3712, C_G = 4096;
constexpr float ALPHA = 1.4142135623730951f;
constexpr int NCHUNK = 64;
constexpr int HG_G = 8;

constexpr size_t MiB = 1u << 20;
constexpr size_t WS_CTL = 0;
constexpr size_t CTL_BYTES = 65536;
constexpr size_t WS_WINT = 2 * MiB;
constexpr size_t WS_WOUTT = 20 * MiB;
constexpr size_t WS_WC1T = 24 * MiB;
constexpr size_t WS_WC2T = 26 * MiB;
constexpr size_t WS_PBP = 26 * MiB + 512 * 1024;
constexpr size_t WS_KC = 27 * MiB;
constexpr size_t WS_VCT = 27 * MiB + 512 * 1024;
constexpr size_t WS_HGU = 28 * MiB;
constexpr size_t WS_HGD = 79 * MiB;
constexpr size_t WS_XH = 80 * MiB;
constexpr size_t WS_MIX = 144 * MiB;
constexpr size_t WS_H = 208 * MiB;
constexpr size_t WS_HGA = 480 * MiB;
constexpr size_t WS_HGDG = 487 * MiB;
constexpr size_t WS_STAT = 488 * MiB;
constexpr size_t WS_END = 489 * MiB;

struct Params { const float* in[13]; float* out; unsigned char* ws; };

__device__ __forceinline__ unsigned pk2h(float a, float b) { h16x2 v = {(h16)a, (h16)b}; return __builtin_bit_cast(unsigned, v); }
typedef __bf16 bf16x2_t __attribute__((ext_vector_type(2)));
__device__ __forceinline__ unsigned pk2b(float lo, float hi) { const f32x2 v = {lo, hi}; return __builtin_bit_cast(unsigned, __builtin_convertvector(v, bf16x2_t)); }
__device__ __forceinline__ float wave_sum(float v) {
#pragma unroll
    for (int o = 1; o < 64; o <<= 1) v += __shfl_xor(v, o);
    return v;
}
__device__ __forceinline__ float xhalf(float x, int hi) {
    auto r = __builtin_amdgcn_permlane32_swap(__float_as_uint(x), __float_as_uint(x), false, false);
    return __uint_as_float(hi ? r[0] : r[1]);
}
__device__ __forceinline__ f32x16 mfma32(h16x8 a, h16x8 b, f32x16 c) { return __builtin_amdgcn_mfma_f32_32x32x16_f16(a, b, c, 0, 0, 0); }
__device__ __forceinline__ f32x4 mfma16(h16x8 a, h16x8 b, f32x4 c) { return __builtin_amdgcn_mfma_f32_16x16x32_f16(a, b, c, 0, 0, 0); }
__device__ __forceinline__ int crow(int r, int hi) { return (r & 3) + 8 * (r >> 2) + 4 * hi; }
namespace pg8 {
#define PG8_LAS __attribute__((address_space(3)))
typedef unsigned short bf16_t;
typedef short bf16x8 __attribute__((ext_vector_type(8)));
typedef float f32x4 __attribute__((ext_vector_type(4)));
typedef unsigned u32x4 __attribute__((ext_vector_type(4)));
constexpr int BM = 256, BK = 64, HALF = 128, HTB = HALF * BK * 2  , STAGE_BYTES = 8 * HTB, NXCD = 8, WGM = 8;

__host__ __device__ __forceinline__ int lds_byte(int r, int c) { const int st = (r >> 4) * 2 + (c >> 5), rr = r & 15, cc = c & 31, ob = rr * 64 + cc * 2; return st * 1024 + (ob ^ (((ob >> 9) & 1) << 5)); }
__host__ __device__ __forceinline__ void stage_rc(int b, int& R, int& C) { const int st = b / 1024, sb = b % 1024, swz = sb ^ (((sb >> 9) & 1) << 5); R = (st >> 1) * 16 + swz / 64; C = (st & 1) * 32 + (swz % 64) / 2; }
__host__ __device__ __forceinline__ int perm32(int rho) { const int n = rho >> 4, i = rho & 15; return 8 * (i >> 2) + 4 * n + (i & 3); }

struct Unit { int pm, pn; };
struct Gemm { const bf16_t* A; const bf16_t* Bt; int M, N, K; };

struct StaticOrder {
    int nM, nN, nwg, G, c;
    __host__ __device__ void init(int M, int N, int G_, int c_) { nM = M / BM; nN = N / BM; nwg = nM * nN; G = G_; c = c_; }
    __host__ __device__ bool next(int i, Unit& u) const {
        const long L = (long)i * G + c; if (L >= nwg) return false;
        int wgid = (int)L; { const int q = nwg / NXCD, r = nwg % NXCD, xcd = wgid % NXCD, off = wgid / NXCD; wgid = (xcd < r ? xcd * (q + 1) : r * (q + 1) + (xcd - r) * q) + off; }
        const int nig = WGM * nN, gid = wgid / nig, fm = gid * WGM, gsz = (nM - fm) < WGM ? (nM - fm) : WGM;
        u.pm = fm + ((wgid % nig) % gsz); u.pn = (wgid % nig) / gsz; return true;
    }
    __device__ __forceinline__ void a_ready(const Unit&) const {}
    __device__ __forceinline__ void done(const Unit&) const {}
};

struct EpiH {
    static constexpr bool PERM = true, AFTER_DRAIN = false;
    _Float16* O; int ldc;
    __device__ __forceinline__ void operator()(const f32x4 (&acc)[2][2][4][2], const Unit& u, int wr, int wc, int fr, int fq) const {
        const int row0 = u.pm * BM + wr * 64 + fr; const int col0 = u.pn * BM + wc * 32 + 8 * fq;
#pragma unroll
        for (int ai = 0; ai < 2; ++ai)
#pragma unroll
            for (int m = 0; m < 4; ++m) { _Float16* rowp = O + (size_t)(row0 + ai * HALF + m * 16) * ldc + col0;
#pragma unroll
                for (int bj = 0; bj < 2; ++bj) { const f32x4 v0 = acc[ai][bj][m][0], v1 = acc[ai][bj][m][1];
                    u32x4 w;
                    if (bj == 0 && (u.pn == 3 || u.pn == 4)) { w.x = pk2b(v0[0], v0[1]); w.y = pk2b(v0[2], v0[3]); w.z = pk2b(v1[0], v1[1]); w.w = pk2b(v1[2], v1[3]); }
                    else { w.x = pk2h(v0[0], v0[1]); w.y = pk2h(v0[2], v0[3]); w.z = pk2h(v1[0], v1[1]); w.w = pk2h(v1[2], v1[3]); }
                    *(u32x4*)(rowp + bj * HALF) = w; } }
    }
};
struct EpiY {
    static constexpr bool PERM = false, AFTER_DRAIN = false;
    const float* base; float* out; float alpha;
    __device__ __forceinline__ void operator()(const f32x4 (&acc)[2][2][4][2], const Unit& u, int wr, int wc, int fr, int fq) const {
        const int col0 = u.pn * BM + wc * 32 + 4 * fq;
#pragma unroll
        for (int ai = 0; ai < 2; ++ai)
#pragma unroll
            for (int m = 0; m < 4; ++m) { const int r = u.pm * BM + ai * HALF + wr * 64 + m * 16 + fr; const size_t off = (size_t)r * 1024 + col0;
#pragma unroll
                for (int bj = 0; bj < 2; ++bj)
#pragma unroll
                    for (int n = 0; n < 2; ++n) { const f32x4 bs = *(const f32x4*)(base + off + bj * HALF + n * 16); *(f32x4*)(out + off + bj * HALF + n * 16) = acc[ai][bj][m][n] + bs * alpha; } }
    }
};
template <class Epi, class Sched, bool ALIGN_EPI = false, bool SP2 = false>
__device__ __forceinline__ void gemm_phase(PG8_LAS unsigned char* lds, const Gemm g, const Sched& S, const Epi& E, int wv) {
    int lane0_ = __builtin_amdgcn_mbcnt_hi(~0u, __builtin_amdgcn_mbcnt_lo(~0u, 0u)); asm volatile("" : "+v"(lane0_)); const int tid_ = wv * 64 + lane0_;
    const int tid = tid_, wid = __builtin_amdgcn_readfirstlane(tid >> 6), lane = tid & 63, wr = wid >> 2, wc = wid & 3, fr = lane & 15, fq = lane >> 4;
    const int K = g.K, nt = K / BK;
    unsigned voffA[2], voffB[2];
#pragma unroll
    for (int i = 0; i < 2; ++i) { int R, C; stage_rc(tid * 16 + i * 8192, R, C); const int Rb = Epi::PERM ? ((R & ~31) + perm32(R & 31)) : R;
        voffA[i] = (unsigned)(R * K + C) * 2u; voffB[i] = (unsigned)(Rb * K + C) * 2u; }
    const size_t kstep = (size_t)(BK * 2);
    const size_t hstep = (size_t)HALF * K * 2;
    const size_t tstep = 2 * hstep;
    const unsigned ldsw = (unsigned)wid * 1024u;
    const int aoff = lds_byte(wr * 64 + fr, fq * 8), boff = lds_byte(wc * 32 + fr, fq * 8);
#define PG8_SA(b, h) (((b) * 2 + (h)) * HTB)
#define PG8_SB(b, h) ((4 + (b) * 2 + (h)) * HTB)
#define PG8_STAGE(bufoff, gbase, voff) do { _Pragma("unroll") for (int _i = 0; _i < 2; ++_i) \
        __builtin_amdgcn_global_load_lds((const unsigned*)((const char*)(gbase) + (voff)[_i]), (PG8_LAS unsigned*)(lds + (bufoff) + ldsw + _i * 8192), 16, 0, 0); } while (0)
#define PG8_LDA(dst, b, h) do { _Pragma("unroll") for (int m = 0; m < 4; ++m) _Pragma("unroll") for (int k = 0; k < 2; ++k) dst[m][k] = *(const PG8_LAS bf16x8*)(lds + PG8_SA(b, h) + aoff + m * 2048 + k * 1024); } while (0)
#define PG8_LDB(dst, b, h) do { _Pragma("unroll") for (int n = 0; n < 2; ++n) _Pragma("unroll") for (int k = 0; k < 2; ++k) dst[n][k] = *(const PG8_LAS bf16x8*)(lds + PG8_SB(b, h) + boff + n * 2048 + k * 1024); } while (0)
#define PG8_MMA(ai, bj, At, Bt) do { __builtin_amdgcn_s_setprio(1); _Pragma("unroll") for (int m = 0; m < 4; ++m) _Pragma("unroll") for (int n = 0; n < 2; ++n) _Pragma("unroll") for (int k = 0; k < 2; ++k) \
        acc[ai][bj][m][n] = __builtin_amdgcn_mfma_f32_16x16x32_f16(__builtin_bit_cast(h16x8, Bt[n][k]), __builtin_bit_cast(h16x8, At[m][k]), acc[ai][bj][m][n], 0, 0, 0); __builtin_amdgcn_s_setprio(0); } while (0)
#define PG8_WAIT_V(n) asm volatile("s_waitcnt vmcnt(" #n ")" ::: "memory")
#define PG8_WAIT_L(n) asm volatile("s_waitcnt lgkmcnt(" #n ")" ::: "memory")
#define PG8_BAR __builtin_amdgcn_s_barrier()
#define PG8_SCHED __builtin_amdgcn_sched_barrier(0)
    Unit cur, nxt; int ui = 0;
    if (!S.next(0, cur)) return;
    f32x4 acc[2][2][4][2];
#pragma unroll
    for (int a = 0; a < 2; ++a)
#pragma unroll
        for (int b = 0; b < 2; ++b)
#pragma unroll
            for (int m = 0; m < 4; ++m)
#pragma unroll
                for (int n = 0; n < 2; ++n) acc[a][b][m][n] = (f32x4){0.f, 0.f, 0.f, 0.f};
    bf16x8 At[4][2], B0[2][2], B1[2][2];
    const char* cA = (const char*)g.A + (size_t)cur.pm * tstep; const char* cB = (const char*)g.Bt + (size_t)cur.pn * tstep;
    S.a_ready(cur);
    if constexpr (SP2) {
        PG8_STAGE(PG8_SB(0, 0), cB, voffB); PG8_STAGE(PG8_SB(0, 1), cB + hstep, voffB); PG8_STAGE(PG8_SA(0, 0), cA, voffA); PG8_STAGE(PG8_SA(0, 1), cA + hstep, voffA);
        if (wr == 1) PG8_BAR;
        PG8_WAIT_V(2); PG8_BAR;
        PG8_STAGE(PG8_SB(1, 0), cB + kstep, voffB); PG8_STAGE(PG8_SA(1, 0), cA + kstep, voffA); PG8_STAGE(PG8_SB(1, 1), cB + hstep + kstep, voffB);
        PG8_WAIT_V(6); PG8_BAR;
    } else {
        PG8_STAGE(PG8_SB(0, 0), cB, voffB); PG8_STAGE(PG8_SA(0, 0), cA, voffA); PG8_STAGE(PG8_SB(0, 1), cB + hstep, voffB); PG8_STAGE(PG8_SA(0, 1), cA + hstep, voffA);
        if (wr == 1) PG8_BAR;
        PG8_WAIT_V(4); PG8_BAR;
        PG8_STAGE(PG8_SB(1, 0), cB + kstep, voffB); PG8_STAGE(PG8_SA(1, 0), cA + kstep, voffA); PG8_STAGE(PG8_SB(1, 1), cB + hstep + kstep, voffB);
        PG8_WAIT_V(6); PG8_BAR;
    }
    for (;;) {
        const bool has_next = S.next(ui + 1, nxt);
        const char* nA = has_next ? (const char*)g.A + (size_t)nxt.pm * tstep : cA; const char* nB = has_next ? (const char*)g.Bt + (size_t)nxt.pn * tstep : cB;
        for (int t = 0; t < nt; t += 2) {
            const bool last = (t == nt - 2);
            const char* a1 = cA + (size_t)(t + 1) * kstep;
            const char* a2 = last ? nA : cA + (size_t)(t + 2) * kstep; const char* b2 = last ? nB : cB + (size_t)(t + 2) * kstep;
            const char* a3 = a2 + kstep; const char* b3 = b2 + kstep;
            if (last && has_next) S.a_ready(nxt);
            if constexpr (SP2) {
            PG8_LDB(B0, 0, 0); PG8_LDB(B1, 0, 1); PG8_SCHED; PG8_LDA(At, 0, 0); PG8_STAGE(PG8_SA(1, 1), a1 + hstep, voffA);
            PG8_WAIT_V(8); PG8_WAIT_L(0); PG8_BAR; PG8_MMA(0, 0, At, B0); PG8_MMA(0, 1, At, B1); PG8_BAR; PG8_SCHED;
            PG8_LDA(At, 0, 1); PG8_STAGE(PG8_SB(0, 0), b2, voffB); PG8_STAGE(PG8_SB(0, 1), b2 + hstep, voffB); PG8_STAGE(PG8_SA(0, 0), a2, voffA);
            PG8_WAIT_V(8); PG8_WAIT_L(0); PG8_BAR; PG8_MMA(1, 0, At, B0); PG8_MMA(1, 1, At, B1); PG8_BAR; PG8_SCHED;
            PG8_LDB(B0, 1, 0); PG8_LDB(B1, 1, 1); PG8_SCHED; PG8_LDA(At, 1, 0); PG8_STAGE(PG8_SA(0, 1), a2 + hstep, voffA);
            PG8_WAIT_V(8); PG8_WAIT_L(0); PG8_BAR; PG8_MMA(0, 0, At, B0); PG8_MMA(0, 1, At, B1); PG8_BAR; PG8_SCHED;
            PG8_LDA(At, 1, 1); PG8_STAGE(PG8_SB(1, 0), b3, voffB); PG8_STAGE(PG8_SB(1, 1), b3 + hstep, voffB); PG8_STAGE(PG8_SA(1, 0), a3, voffA);
            PG8_WAIT_V(8); PG8_WAIT_L(0); PG8_BAR; PG8_MMA(1, 0, At, B0); PG8_MMA(1, 1, At, B1); PG8_BAR; PG8_SCHED;
            } else {
            PG8_LDB(B0, 0, 0); PG8_SCHED; PG8_LDA(At, 0, 0); PG8_STAGE(PG8_SA(1, 1), a1 + hstep, voffA);
            PG8_WAIT_L(8); PG8_BAR; PG8_WAIT_L(0); PG8_MMA(0, 0, At, B0); PG8_BAR; PG8_SCHED;
            PG8_LDB(B1, 0, 1); PG8_STAGE(PG8_SB(0, 0), b2, voffB);
            PG8_BAR; PG8_WAIT_L(0); PG8_MMA(0, 1, At, B1); PG8_BAR;
            PG8_LDA(At, 0, 1); PG8_STAGE(PG8_SA(0, 0), a2, voffA);
            PG8_BAR; PG8_WAIT_L(0); PG8_MMA(1, 0, At, B0); PG8_BAR; PG8_SCHED;
            PG8_STAGE(PG8_SB(0, 1), b2 + hstep, voffB);
            PG8_WAIT_V(6); PG8_BAR; PG8_MMA(1, 1, At, B1); PG8_BAR;
            PG8_LDB(B0, 1, 0); PG8_SCHED; PG8_LDA(At, 1, 0); PG8_STAGE(PG8_SA(0, 1), a2 + hstep, voffA);
            PG8_WAIT_L(8); PG8_BAR; PG8_WAIT_L(0); PG8_MMA(0, 0, At, B0); PG8_BAR; PG8_SCHED;
            PG8_LDB(B1, 1, 1); PG8_STAGE(PG8_SB(1, 0), b3, voffB);
            PG8_BAR; PG8_WAIT_L(0); PG8_MMA(0, 1, At, B1); PG8_BAR;
            PG8_LDA(At, 1, 1); PG8_STAGE(PG8_SA(1, 0), a3, voffA);
            PG8_BAR; PG8_WAIT_L(0); PG8_MMA(1, 0, At, B0); PG8_BAR; PG8_SCHED;
            PG8_STAGE(PG8_SB(1, 1), b3 + hstep, voffB);
            PG8_WAIT_V(6); PG8_BAR; PG8_MMA(1, 1, At, B1); PG8_BAR;
            }
        }
        if constexpr (ALIGN_EPI) { if (wr == 0) PG8_BAR; }
        if constexpr (!Epi::AFTER_DRAIN) { E(acc, cur, wr, wc, fr, fq); S.done(cur); }
        if (!has_next) break;
#pragma unroll
        for (int a = 0; a < 2; ++a)
#pragma unroll
            for (int b = 0; b < 2; ++b)
#pragma unroll
                for (int m = 0; m < 4; ++m)
#pragma unroll
                    for (int n = 0; n < 2; ++n) acc[a][b][m][n] = (f32x4){0.f, 0.f, 0.f, 0.f};
        cur = nxt; cA = nA; cB = nB; ++ui;
        if constexpr (ALIGN_EPI) { if (wr == 1) PG8_BAR; }
    }
    PG8_WAIT_V(0);
    if constexpr (!ALIGN_EPI) { if (wr == 0) PG8_BAR; }
    PG8_BAR;
    if constexpr (Epi::AFTER_DRAIN) { E.fused(acc, cur, wr, wc, fr, fq, lds, wid, lane); S.done(cur); }
#undef PG8_SA
#undef PG8_SB
#undef PG8_STAGE
#undef PG8_LDA
#undef PG8_LDB
#undef PG8_MMA
#undef PG8_WAIT_V
#undef PG8_WAIT_L
#undef PG8_BAR
#undef PG8_SCHED
}
}

#define XB_TMO      128
#define XB_XCNT(j)  (256  + 64 * (j))
#define XB_XSUB(j)  (1280 + 64 * (j))
#define XB_XGEN(j)  (2304 + 64 * (j))
#define XB_TOP      3328
#define XB_TOPGEN   3392
#define XCD_BAR_WORDS 3456
#define XB_SPIN_CAP (1u << 18)

__device__ __forceinline__ unsigned xb_ld(unsigned* p)              { return __hip_atomic_load(p, __ATOMIC_RELAXED, __HIP_MEMORY_SCOPE_AGENT); }
__device__ __forceinline__ unsigned xb_add(unsigned* p, unsigned v) { return __hip_atomic_fetch_add(p, v, __ATOMIC_RELAXED, __HIP_MEMORY_SCOPE_AGENT); }
__device__ __forceinline__ unsigned xb_xcc_id() { return (unsigned)__builtin_amdgcn_s_getreg((3 << 11) | 20) & 0xFu; }
#define XB_SPIN(cond, bar) do { unsigned _sp = 0; while (cond) { __builtin_amdgcn_s_sleep(1); \
    if ((++_sp & 255u) == 0u) { if (xb_ld(&(bar)[XB_TMO])) break; if (_sp > XB_SPIN_CAP) { atomicAdd(&(bar)[XB_TMO], 1u); break; } } } } while (0)

struct XcdBarrier {
    unsigned* bar; unsigned x;
    volatile LAS unsigned* st;
};

__device__ __forceinline__ XcdBarrier xcd_barrier_post(unsigned* bar, volatile LAS unsigned* st) {
    XcdBarrier b; b.bar = bar; b.x = xb_xcc_id(); b.st = st;
    if (threadIdx.x == 0) (void)xb_add(&bar[XB_XCNT(b.x)], 1u);
    return b;
}
__device__ __forceinline__ void xcd_barrier_complete(unsigned* bar, unsigned x, unsigned& nloc, unsigned& nx) {
    const unsigned G = gridDim.x * gridDim.y * gridDim.z;
    unsigned sum, cnt, mine, sp = 0u;
    for (;;) {
        sum = 0u; cnt = 0u; mine = 0u;
#pragma unroll
        for (unsigned j = 0; j < 16; ++j) { const unsigned c = xb_ld(&bar[XB_XCNT(j)]); sum += c; cnt += (c > 0u) ? 1u : 0u; mine = (j == x) ? c : mine; }
        if (sum == G) break;
        __builtin_amdgcn_s_sleep(1);
        if ((++sp & 255u) == 0u) { if (xb_ld(&bar[XB_TMO])) break; if (sp > XB_SPIN_CAP) { atomicAdd(&bar[XB_TMO], 1u); break; } }
    }
    nloc = mine > 0u ? mine : 1u; nx = cnt > 0u ? cnt : 1u;
}

__device__ __forceinline__ void xcd_barrier(const XcdBarrier& b, int wv) {
    asm volatile("s_waitcnt vmcnt(0)" ::: "memory");
    __syncthreads();
    if (wv == 0 && __builtin_amdgcn_mbcnt_hi(~0u, __builtin_amdgcn_mbcnt_lo(~0u, 0u)) == 0) {
        unsigned* bar = b.bar;
        __builtin_amdgcn_s_waitcnt(0);
        unsigned nloc = b.st[0], nx = b.st[1];
        if (nloc == 0u) { xcd_barrier_complete(bar, b.x, nloc, nx); b.st[0] = nloc; b.st[1] = nx; }
        const unsigned old = xb_add(&bar[XB_XSUB(b.x)], 1u);
        const unsigned gen = old / nloc;
        if (old + 1u == (gen + 1u) * nloc) {
            __builtin_amdgcn_fence(__ATOMIC_RELEASE, "agent");
            asm volatile("s_waitcnt vmcnt(0)" ::: "memory");
            const unsigned og = xb_add(&bar[XB_TOP], 1u);
            const unsigned tg = og / nx;
            if (og + 1u == (tg + 1u) * nx) xb_add(&bar[XB_TOPGEN], 1u);
            else XB_SPIN(xb_ld(&bar[XB_TOPGEN]) == tg, bar);
            __builtin_amdgcn_fence(__ATOMIC_ACQUIRE, "agent");
            xb_add(&bar[XB_XGEN(b.x)], 1u);
            asm volatile("s_waitcnt vmcnt(0)" ::: "memory");
        } else {
            XB_SPIN(xb_ld(&bar[XB_XGEN(b.x)]) == gen, bar);
            __builtin_amdgcn_fence(__ATOMIC_ACQUIRE, "agent");
            asm volatile("s_waitcnt vmcnt(0)" ::: "memory");
        }
    }
    __syncthreads();
}

#define PHASE_IDS() int lane_ = __builtin_amdgcn_mbcnt_hi(~0u, __builtin_amdgcn_mbcnt_lo(~0u, 0u)); asm volatile("" : "+v"(lane_)); const int lane = lane_, wave = wv, tid = wv * 64 + lane_; (void)lane; (void)wave; (void)tid; unsigned char* ws = p.ws; asm volatile("" : "+s"(ws))
typedef short v4i16_t __attribute__((ext_vector_type(4)));
__device__ __forceinline__ h16x4 tr_read4(const LAS unsigned char* p) { return __builtin_bit_cast(h16x4, __builtin_amdgcn_ds_read_tr16_b64_v4i16((LAS v4i16_t*)p)); }
__device__ __forceinline__ h16x8 vt_frag(const LAS unsigned char* vimg, int half_bytes, int et, int st, int lane) {
    const int hi = lane >> 5, blk = (lane >> 4) & 1, q = (lane & 15) >> 2, pp = lane & 3;
    const LAS unsigned char* a = vimg + et * half_bytes + (16 * st + 4 * hi + q) * 64 + (16 * blk + 4 * pp) * 2;
    const h16x4 lo = tr_read4(a), hh = tr_read4(a + 8 * 64);
    return (h16x8){lo[0], lo[1], lo[2], lo[3], hh[0], hh[1], hh[2], hh[3]};
}
__device__ __forceinline__ float silu_f(float z) { return z / (1.f + __expf(-z)); }

constexpr int SBL_K = 0, SBL_KB = 4608, SBL_V = 9216, SBL_VB = 4096, SBL_FLAG = 17408;
__device__ __forceinline__ void sb_unit(const Params& p, int unit, LAS unsigned char* lds, int wv) {
    PHASE_IDS();
    const h16* H = (const h16*)(ws + WS_H); h16* MIX = (h16*)(ws + WS_MIX);
    const int qb = unit & 15, bh = unit >> 4, hh = bh & 3, b = bh >> 2;
    const int r32 = lane & 31, hi = lane >> 5;
    const int t0 = 256 * qb, tb = t0 + 32 * wave, Ttop = 8 * qb + 7, Tdiag = 8 * qb + wave;
    LAS int* flags = (LAS int*)(lds + SBL_FLAG);
    const size_t qrow = (size_t)(b * SEQ + tb + r32) * NH;
    h16x8 qf[4];
#pragma unroll
    for (int ks = 0; ks < 4; ++ks) { qf[ks] = *(const h16x8*)(H + qrow + C_SQ + hh * 64 + 16 * ks + 8 * hi); qf[ks] = qf[ks] * (h16)0.125f; }
    f32x16 o0 = {}, o1 = {};
    float R = 1.f; bool done = false;
    const int li = tid & 255, lrow = li >> 3, lc = li & 7; const bool isV = tid >= 256;
    const h16* gsrc = H + (size_t)(b * SEQ + lrow) * NH + (isV ? C_SV : C_SK) + hh * 64 + 8 * lc;
    const int ldst = isV ? SBL_V + (lc >> 2) * 2048 + lrow * 64 + (lc & 3) * 16 : SBL_K + lrow * 144 + lc * 16;
    const int lbuf = isV ? SBL_VB : SBL_KB;
    { const u32x4 v = *(const u32x4*)(gsrc + (size_t)Ttop * 32 * NH); *(LAS u32x4*)(lds + ldst) = v; }
    __syncthreads();
    int buf = 0, it = 0;
    for (int T = Ttop; T >= 0; --T, ++it) {
        u32x4 nxt = {0u, 0u, 0u, 0u};
        if (T > 0) nxt = *(const u32x4*)(gsrc + (size_t)(T - 1) * 32 * NH);
        if (T <= Tdiag && !done) {
            const LAS unsigned char* kimg = lds + SBL_K + buf * SBL_KB; const LAS unsigned char* vimg = lds + SBL_V + buf * SBL_VB;
            f32x16 z = {};
#pragma unroll
            for (int ks = 0; ks < 4; ++ks) { const h16x8 kf = *(const LAS h16x8*)(kimg + r32 * 144 + (16 * ks + 8 * hi) * 2); z = mfma32(kf, qf[ks], z); }
            float om[16], be[16];
            const bool diag = (T == Tdiag);
#pragma unroll
            for (int r = 0; r < 16; ++r) {
                const float u = __expf(fminf(z[r], 80.f)), rr = __builtin_amdgcn_rcpf(1.f + u);
                const bool valid = !diag || (crow(r, hi) < r32);
                om[r] = valid ? rr : 1.f; be[r] = valid ? u * rr : 0.f;
            }
            float G[4], Gp[4];
#pragma unroll
            for (int g = 0; g < 4; ++g) { G[g] = (om[4 * g] * om[4 * g + 1]) * (om[4 * g + 2] * om[4 * g + 3]); Gp[g] = xhalf(G[g], hi); }
            float E[4]; float run = R;
#pragma unroll
            for (int g = 3; g >= 0; --g) { E[g] = hi ? run : run * Gp[g]; run = run * (G[g] * Gp[g]); }
            h16x8 pf[2];
#pragma unroll
            for (int g = 0; g < 4; ++g) {
                const float w3 = E[g], w2 = w3 * om[4 * g + 3], w1 = w2 * om[4 * g + 2], w0 = w1 * om[4 * g + 1];
                pf[g >> 1][4 * (g & 1) + 0] = (h16)(be[4 * g + 0] * w0); pf[g >> 1][4 * (g & 1) + 1] = (h16)(be[4 * g + 1] * w1);
                pf[g >> 1][4 * (g & 1) + 2] = (h16)(be[4 * g + 2] * w2); pf[g >> 1][4 * (g & 1) + 3] = (h16)(be[4 * g + 3] * w3);
            }
            R = run;
#pragma unroll
            for (int st = 0; st < 2; ++st) {
                o0 = mfma32(vt_frag(vimg, 2048, 0, st, lane), pf[st], o0);
                o1 = mfma32(vt_frag(vimg, 2048, 1, st, lane), pf[st], o1);
            }
            done = (__builtin_amdgcn_ballot_w64(R >= 1e-37f) == 0ull);
        }
        if (T > 0) *(LAS u32x4*)(lds + ldst + (buf ^ 1) * lbuf) = nxt;
        if (lane == 0) flags[(it & 1) * 8 + wave] = done ? 1 : 0;
        __syncthreads();
        int alld = 1;
#pragma unroll
        for (int w = 0; w < 8; ++w) alld &= flags[(it & 1) * 8 + w];
        if (alld) break;
        buf ^= 1;
    }
#pragma unroll
    for (int et = 0; et < 2; ++et)
#pragma unroll
        for (int g = 0; g < 4; ++g) {
            const int e = 32 * et + 8 * g + 4 * hi;
            const h16x4 zz = *(const h16x4*)(H + qrow + C_SZ + hh * 64 + e);
            h16x4 ov;
#pragma unroll
            for (int i = 0; i < 4; ++i) { const float ov_f = (et ? o1[4 * g + i] : o0[4 * g + i]); ov[i] = (h16)(ov_f * silu_f((float)zz[i])); }
            *(h16x4*)(MIX + (size_t)(b * SEQ + tb + r32) * DM + 384 + hh * 64 + e) = ov;
        }
    __syncthreads();
}

constexpr int NSL_K = 0, NSL_KB = 9216, NSL_V = 18432, NSL_VB = 8192, NSL_BT = 34816, NSL_IMP = 36864, NSL_Q = NSL_IMP + 8 * 16 * 65 * 4, NSL_END = NSL_Q + 8 * 6 * 1024;
constexpr int REP_SEL = 1, REP_WIN = 1, XTRA_BAR = 0;
constexpr float NSA_NEG = -1e30f, NSA_MINIT = -1e20f, NSA_THR = 10.f;
struct NsaW { const LAS h16x8* qf; f32x4 o[3][4]; f32x4 cvv, mv, lv; f32x4 la[3]; };
#define WCV(hh) W.cvv[hh]
#define WM(hh) W.mv[hh]
#define WL(hh) W.lv[hh]
typedef short s16x8 __attribute__((ext_vector_type(8)));
__device__ __forceinline__ f32x4 mfma16b(h16x8 vfrag, u32x4 p, f32x4 c) { return __builtin_amdgcn_mfma_f32_16x16x32_bf16(__builtin_bit_cast(s16x8, vfrag), __builtin_bit_cast(s16x8, p), c, 0, 0, 0); }
__device__ __forceinline__ float vmax3(float a, float b, float c) { float r; asm("v_max3_f32 %0, %1, %2, %3" : "=v"(r) : "v"(a), "v"(b), "v"(c)); return r; }
__device__ __forceinline__ float max4(float v, int hi) { v = fmaxf(v, __shfl_xor(v, 16)); return fmaxf(v, xhalf(v, hi)); }
__device__ __forceinline__ float sum4(float v, int hi) { v += __shfl_xor(v, 16); return v + xhalf(v, hi); }

template <int MODE>
__device__ __forceinline__ void nsa_pass(NsaW& W, const h16* kbase, const h16* vbase, int pitch, int kt_lo, int kt_hi, int tw, int t, unsigned long long sel,
                                         LAS unsigned char* lds, const LAS float* BT, LAS float* impw, int tid, int lane, int wave) {
    const int fr = lane & 15, kq = lane >> 4, hi = lane >> 5;
    const int lc = tid & 7, lr0 = tid >> 3, maxrow = 32 * kt_hi + 31;
    const int kdst0 = NSL_K + lr0 * 144 + lc * 16;
    const int vdst0 = NSL_V + (lr0 >> 5) * 4096 + (lc >> 2) * 2048 + (lr0 & 31) * 64 + (lc & 3) * 16;
    const int stg_lo = kt_lo >> 1, stg_hi = kt_hi >> 1;
#define NSA_STAGE_LOAD(stg, k0, v0) do { int r0_ = 64 * (stg) + lr0; r0_ = r0_ > maxrow ? maxrow : r0_; \
        k0 = *(const u32x4*)(kbase + (size_t)r0_ * pitch + 8 * lc); v0 = *(const u32x4*)(vbase + (size_t)r0_ * pitch + 8 * lc); } while (0)
#define NSA_STAGE_STORE(b, k0, v0) do { *(LAS u32x4*)(lds + kdst0 + (b) * NSL_KB) = k0; *(LAS u32x4*)(lds + vdst0 + (b) * NSL_VB) = v0; } while (0)
    { u32x4 k0, v0; NSA_STAGE_LOAD(stg_lo, k0, v0); NSA_STAGE_STORE(0, k0, v0); }
    __syncthreads();
    int buf = 0; float prev_carry = 0.f; bool first = true;
    for (int stg = stg_lo; stg <= stg_hi; ++stg) {
        u32x4 nk0 = {0u, 0u, 0u, 0u}, nv0 = nk0;
        if (stg < stg_hi) NSA_STAGE_LOAD(stg + 1, nk0, nv0);
      for (int h2 = 0; h2 < 2; ++h2) {
        const int kt = 2 * stg + h2;
        bool act = (kt >= kt_lo) && (kt <= kt_hi);
        if (MODE <= 1) act = act && (512 * kt + 16 <= tw);
        else if (MODE == 2) act = act && (32 * kt <= tw + 15) && (__builtin_amdgcn_ballot_w64((sel >> stg) & 1ull) != 0ull);
        else act = act && !(32 * kt + 31 < tw - 511 || 32 * kt > tw + 15);
        if (act) {
            const LAS unsigned char* kimg = lds + NSL_K + buf * NSL_KB + h2 * (32 * 144); const LAS unsigned char* vimg = lds + NSL_V + buf * NSL_VB + h2 * 4096;
            h16x8 kf[2][2];
#pragma unroll
            for (int sub = 0; sub < 2; ++sub)
#pragma unroll
                for (int ks = 0; ks < 2; ++ks) kf[sub][ks] = *(const LAS h16x8*)(kimg + (16 * sub + fr) * 144 + (32 * ks + 8 * kq) * 2);
            h16x8 vf[4];
            if (MODE != 0) {
#pragma unroll
                for (int et = 0; et < 4; ++et) {
                    const LAS unsigned char* a = vimg + (et >> 1) * 2048 + (4 * kq + ((lane & 15) >> 2)) * 64 + (16 * (et & 1) + 4 * (lane & 3)) * 2;
                    const h16x4 lo = tr_read4(a), hh4 = tr_read4(a + 16 * 64);
                    vf[et] = (h16x8){lo[0], lo[1], lo[2], lo[3], hh4[0], hh4[1], hh4[2], hh4[3]};
                }
            }
            const bool selbit = (MODE == 2) ? (((sel >> stg) & 1ull) != 0ull) : true;
            const int relmin = (MODE <= 1) ? tw - (16 * (32 * kt + 31) + 31) : tw - (32 * kt + 31);
            const bool farflag = (relmin >= 113) && (MODE != 3 || (tw + 15 - 32 * kt) < 512);
            float Lloc[2] = {0.f, 0.f}, Llast[2] = {0.f, 0.f};
            const unsigned mk = selbit ? 0xffffffffu : 0u;
            f32x4 sn[2];
            { const h16x8 q0 = W.qf[0 * 64 + lane], q1 = W.qf[1 * 64 + lane];
#pragma unroll
              for (int sub = 0; sub < 2; ++sub) { sn[sub] = mfma16(kf[sub][0], q0, (f32x4){0.f, 0.f, 0.f, 0.f}); sn[sub] = mfma16(kf[sub][1], q1, sn[sub]); } }
#pragma unroll
            for (int hh = 0; hh < 3; ++hh) {
                f32x4 s[2]; s[0] = sn[0]; s[1] = sn[1];
                if (hh < 2) { const h16x8 q0 = W.qf[((hh + 1) * 2 + 0) * 64 + lane], q1 = W.qf[((hh + 1) * 2 + 1) * 64 + lane];
#pragma unroll
                  for (int sub = 0; sub < 2; ++sub) { sn[sub] = mfma16(kf[sub][0], q0, (f32x4){0.f, 0.f, 0.f, 0.f}); sn[sub] = mfma16(kf[sub][1], q1, sn[sub]); } }
                if (!farflag) {
                    const float nb = -BT[hh * 128 + 127];
                    float bb[2][4];
#pragma unroll
                    for (int sub = 0; sub < 2; ++sub)
#pragma unroll
                        for (int r = 0; r < 4; ++r) {
                            const int key = 32 * kt + 16 * sub + 4 * kq + r;
                            const int rel = (MODE <= 1) ? t - (16 * key + 31) : t - key;
                            const int ri = rel < 0 ? 0 : (rel > 127 ? 127 : rel);
                            bb[sub][r] = ((const volatile LAS float*)BT)[hh * 128 + ri];
                        }
#pragma unroll
                    for (int sub = 0; sub < 2; ++sub)
#pragma unroll
                        for (int r = 0; r < 4; ++r) {
                            const int key = 32 * kt + 16 * sub + 4 * kq + r;
                            const int rel = (MODE <= 1) ? t - (16 * key + 31) : t - key;
                            bool v = rel >= 0;
                            if (MODE == 3) v = v && rel < 512;
                            s[sub][r] = v ? s[sub][r] + (bb[sub][r] + nb) : NSA_NEG;
                        }
                }
#pragma unroll
                for (int sub = 0; sub < 2; ++sub)
#pragma unroll
                    for (int r = 0; r < 4; ++r) s[sub][r] = __builtin_amdgcn_exp2f(s[sub][r]);
                if (MODE == 0) {
                    WL(hh) += ((s[0][0] + s[0][1]) + (s[0][2] + s[0][3])) + ((s[1][0] + s[1][1]) + (s[1][2] + s[1][3]));
                } else {
                    if (MODE == 1) {
#pragma unroll
                        for (int sub = 0; sub < 2; ++sub) { s[sub] = s[sub] * WL(hh); Lloc[sub] += (s[sub][0] + s[sub][1]) + (s[sub][2] + s[sub][3]); Llast[sub] += s[sub][3]; }
                    }
                    u32x4 pu; pu.x = pk2b(s[0][0], s[0][1]); pu.y = pk2b(s[0][2], s[0][3]); pu.z = pk2b(s[1][0], s[1][1]); pu.w = pk2b(s[1][2], s[1][3]);
                    if (MODE == 2) { pu.x &= mk; pu.y &= mk; pu.z &= mk; pu.w &= mk; }
                    if (MODE >= 2) { const u32x4 ones = {0x3f803f80u, 0x3f803f80u, 0x3f803f80u, 0x3f803f80u}; W.la[hh] = __builtin_amdgcn_mfma_f32_16x16x32_bf16(__builtin_bit_cast(s16x8, ones), __builtin_bit_cast(s16x8, pu), W.la[hh], 0, 0, 0); }
#pragma unroll
                    for (int et = 0; et < 4; ++et) W.o[hh][et] = mfma16b(vf[et], pu, W.o[hh][et]);
                }
            }
            first = false;
            if (MODE == 1) {
                const float up0 = __shfl(Llast[0], (lane - 16) & 63), up1 = __shfl(Llast[1], (lane - 16) & 63);
                const float own0 = Lloc[0] + (kq ? up0 : prev_carry), own1 = Lloc[1] + (kq ? up1 : up0);
                prev_carry = up1;
                impw[fr * 65 + 8 * kt + kq] = own0; impw[fr * 65 + 8 * kt + 4 + kq] = own1;
            }
        }
      }
        if (stg < stg_hi) NSA_STAGE_STORE(buf ^ 1, nk0, nv0);
        __syncthreads();
        if (MODE == 2) for (int xb = 0; xb < XTRA_BAR; ++xb) __syncthreads();
        buf ^= 1;
    }
#undef NSA_STAGE_LOAD
#undef NSA_STAGE_STORE
}

__device__ __forceinline__ void nsa_unit(const Params& p, int unit, LAS unsigned char* lds, int wv) {
    PHASE_IDS();
    const h16* H = (const h16*)(ws + WS_H); h16* MIX = (h16*)(ws + WS_MIX);
    const int ub = 31 - (unit >> 4), bg = unit & 15, g = bg & 1, b = bg >> 1;
    const int fr = lane & 15, kq = lane >> 4, hi = lane >> 5;
    const int t0 = 128 * ub, tw = t0 + 16 * wave, t = tw + fr, cur = tw >> 6;
    LAS float* BT = (LAS float*)(lds + NSL_BT); LAS float* impw = (LAS float*)(lds + NSL_IMP) + wave * (16 * 65);
    if (tid < 384) { const int hh = tid >> 7, d = tid & 127; int bk = d;
        if (d >= 16) bk = 16 + (d >= 19) + (d >= 21) + (d >= 24) + (d >= 27) + (d >= 31) + (d >= 35) + (d >= 40) + (d >= 46) + (d >= 52) + (d >= 59) + (d >= 67) + (d >= 77) + (d >= 87) + (d >= 99) + (d >= 113);
        BT[tid] = p.in[12][bk * 6 + g * 3 + hh] * 1.4426950408889634f; }
    for (int i = lane; i < 16 * 65; i += 64) impw[i] = 0.f;
    const size_t hrow = (size_t)(b * SEQ + t) * NH;
    NsaW W; { LAS h16x8* qw = (LAS h16x8*)(lds + NSL_Q) + wave * (6 * 64); W.qf = qw;
#pragma unroll
    for (int hh = 0; hh < 3; ++hh)
#pragma unroll
        for (int ks = 0; ks < 2; ++ks) { h16x8 q = *(const h16x8*)(H + hrow + C_NQ + (g * 3 + hh) * 64 + 32 * ks + 8 * kq); qw[(hh * 2 + ks) * 64 + lane] = q * (h16)(0.125f * 1.4426950408889634f); } }
#define NSA_GATE(hh, i) (1.f / (1.f + __expf(-(float)H[hrow + C_G + (g * 3 + (hh)) * 3 + (i)])))
#define NSA_ACC(hh, et, scale, FIRST, LAST) do { const int e_ = 16 * (et) + 4 * kq, hc_ = (g * 3 + (hh)) * 64 + e_; h16* dst_ = MIX + (size_t)(b * SEQ + t) * DM + hc_; \
        f32x4 a_ = W.o[hh][et] * (scale); \
        if (!(FIRST)) { const h16x4 d_ = *(const h16x4*)dst_; a_ = a_ + (f32x4){(float)d_[0], (float)d_[1], (float)d_[2], (float)d_[3]}; } \
        if (LAST) { const h16x4 zz_ = *(const h16x4*)(H + hrow + C_NZ + hc_); a_ = a_ * (f32x4){silu_f((float)zz_[0]), silu_f((float)zz_[1]), silu_f((float)zz_[2]), silu_f((float)zz_[3])}; } \
        *(h16x4*)dst_ = (h16x4){(h16)a_[0], (h16)a_[1], (h16)a_[2], (h16)a_[3]}; } while (0)
    __syncthreads();
    const h16* KC = (const h16*)(ws + WS_KC) + (size_t)bg * 256 * 64; const h16* VC = (const h16*)(ws + WS_VCT) + (size_t)bg * 256 * 64;
    const int ct_hi = (t0 + 127 - 16) / 512;
#pragma unroll
    for (int hh = 0; hh < 3; ++hh) WL(hh) = 0.f;
    nsa_pass<0>(W, KC, VC, 64, 0, ct_hi, tw, t, 0ull, lds, BT, impw, tid, lane, wave);
#pragma unroll
    for (int hh = 0; hh < 3; ++hh) { const float lr = sum4(WL(hh), hi); WL(hh) = lr > 0.f ? 1.f / lr : 0.f;
#pragma unroll
        for (int et = 0; et < 4; ++et) W.o[hh][et] = (f32x4){0.f, 0.f, 0.f, 0.f}; }
    nsa_pass<1>(W, KC, VC, 64, 0, ct_hi, tw, t, 0ull, lds, BT, impw, tid, lane, wave);
#pragma unroll
    for (int hh = 0; hh < 3; ++hh) { const float sc = NSA_GATE(hh, 0);
#pragma unroll
        for (int et = 0; et < 4; ++et) NSA_ACC(hh, et, sc, true, false); }
    asm volatile("s_waitcnt lgkmcnt(0)" ::: "memory");
    unsigned long long sel;
    if (cur <= 15) sel = (2ull << cur) - 1ull;
    else {
        float v[16];
#pragma unroll
        for (int i = 0; i < 16; ++i) { const int j = 4 * i + kq; v[i] = (j >= 1 && j <= cur - 2) ? impw[fr * 65 + j] : -1.f; }
        sel = 1ull | (3ull << (cur - 1));
        for (int round = 0; round < 13; ++round) {
            float bv = v[0]; int bj = kq;
#pragma unroll
            for (int i = 1; i < 16; ++i) if (v[i] > bv) { bv = v[i]; bj = 4 * i + kq; }
            { const float ov = __shfl_xor(bv, 16); const int oj = __shfl_xor(bj, 16); if (ov > bv || (ov == bv && oj < bj)) { bv = ov; bj = oj; } }
            { const float ov = __shfl_xor(bv, 32); const int oj = __shfl_xor(bj, 32); if (ov > bv || (ov == bv && oj < bj)) { bv = ov; bj = oj; } }
            sel |= 1ull << bj;
#pragma unroll
            for (int i = 0; i < 16; ++i) v[i] = (4 * i + kq == bj) ? -1.f : v[i];
        }
    }
    const h16* Hb = H + (size_t)b * SEQ * NH;
    for (int rep = 0; rep < REP_SEL; ++rep) {
#pragma unroll
    for (int hh = 0; hh < 3; ++hh) { W.la[hh] = (f32x4){0.f, 0.f, 0.f, 0.f};
#pragma unroll
        for (int et = 0; et < 4; ++et) W.o[hh][et] = (f32x4){0.f, 0.f, 0.f, 0.f}; }
    nsa_pass<2>(W, Hb + C_KS + g * 64, Hb + C_VS + g * 64, NH, 0, (t0 + 127) >> 5, tw, t, sel, lds, BT, impw, tid, lane, wave);
    }
#pragma unroll
    for (int hh = 0; hh < 3; ++hh) { const float lr = W.la[hh][0]; const float sc = lr > 0.f ? NSA_GATE(hh, 1) / lr : 0.f;
#pragma unroll
        for (int et = 0; et < 4; ++et) NSA_ACC(hh, et, sc, false, false); }
    for (int rep = 0; rep < REP_WIN; ++rep) {
#pragma unroll
    for (int hh = 0; hh < 3; ++hh) { W.la[hh] = (f32x4){0.f, 0.f, 0.f, 0.f};
#pragma unroll
        for (int et = 0; et < 4; ++et) W.o[hh][et] = (f32x4){0.f, 0.f, 0.f, 0.f}; }
    nsa_pass<3>(W, Hb + C_KW + g * 64, Hb + C_VW + g * 64, NH, (t0 - 511 < 0) ? 0 : (t0 - 511) >> 5, (t0 + 127) >> 5, tw, t, 0ull, lds, BT, impw, tid, lane, wave);
    }
#pragma unroll
    for (int hh = 0; hh < 3; ++hh) { const float lr = W.la[hh][0]; const float sc = lr > 0.f ? NSA_GATE(hh, 2) / lr : 0.f;
#pragma unroll
        for (int et = 0; et < 4; ++et) NSA_ACC(hh, et, sc, false, true); }
    __syncthreads();
}

#define LDS_WAIT() asm volatile("s_waitcnt lgkmcnt(0)" ::: "memory")
__device__ __forceinline__ void tr_item(const float* W, int ldw, int srccol0, h16* WT, int K, int dstrow0, int k0, LAS float* scr, int lane) {
#pragma unroll 8
    for (int i = 0; i < 32; ++i) { const int kk = 2 * i + (lane >> 5); scr[kk * 33 + (lane & 31)] = srccol0 >= 0 ? W[(size_t)(k0 + kk) * ldw + srccol0 + (lane & 31)] : 0.f; }
    LDS_WAIT(); asm volatile("" ::: "memory");
    const int c = lane & 7;
#pragma unroll
    for (int j = 0; j < 4; ++j) { const int n = (lane >> 3) + 8 * j; const LAS float* s = scr + (8 * c) * 33 + n;
        u32x4 o; o.x = pk2h(s[0 * 33], s[1 * 33]); o.y = pk2h(s[2 * 33], s[3 * 33]); o.z = pk2h(s[4 * 33], s[5 * 33]); o.w = pk2h(s[6 * 33], s[7 * 33]);
        *(u32x4*)(WT + (size_t)(dstrow0 + n) * K + k0 + 8 * c) = o; }
    LDS_WAIT(); asm volatile("" ::: "memory");
}

__device__ __forceinline__ void prologue(const Params& p, LAS unsigned char* lds, int wv) {
    PHASE_IDS();
    LAS float* scr = (LAS float*)(lds + wave * 16384);
    const int gw = blockIdx.x * 8 + wave, NGW = gridDim.x * 8;
    constexpr int I_IN = 16 * (NH / 32), I_OUT = 16 * 32, I_C1 = 32 * 4, I_C2 = 2 * 2;
    constexpr int N_IN = 2 * I_IN, N_OUT = 2 * I_OUT, N_C1 = 4 * I_C1, N_C2 = 4 * I_C2, N_PB = 128;
    constexpr int NITEMS = N_IN + N_OUT + N_C1 + N_C2 + N_PB;
    for (int it = gw; it < NITEMS; it += NGW) {
        int r = it;
        if (r < N_IN) { const int l = r / I_IN, q = r % I_IN, kb = q / (NH / 32), nb = q % (NH / 32), n0 = 32 * nb;
            const int src = n0 < 1152 ? n0 : (n0 < 4096 ? n0 + 18 : (n0 == 4096 ? 1152 : -1));
            tr_item(p.in[1] + (size_t)l * 1024 * DIN, DIN, src, (h16*)(ws + WS_WINT) + (size_t)l * NH * 1024, 1024, n0, 64 * kb, scr, lane); continue; }
        r -= N_IN;
        if (r < N_OUT) { const int l = r / I_OUT, q = r % I_OUT, kb = q / 32, nb = q % 32;
            tr_item(p.in[9] + (size_t)l * 1024 * 1024, 1024, 32 * nb, (h16*)(ws + WS_WOUTT) + (size_t)l * 1024 * 1024, 1024, 32 * nb, 64 * kb, scr, lane); continue; }
        r -= N_OUT;
        if (r < N_C1) { const int lk = r / I_C1, l = lk >> 1, kv = lk & 1, q = r % I_C1, kb = q / 4, nb = q % 4;
            tr_item((kv ? p.in[5] : p.in[3]) + (size_t)l * 2048 * 128, 128, 32 * nb, (h16*)(ws + WS_WC1T) + (size_t)lk * 128 * 2048, 2048, 32 * nb, 64 * kb, scr, lane); continue; }
        r -= N_C1;
        if (r < N_C2) { const int lk = r / I_C2, l = lk >> 1, kv = lk & 1, q = r % I_C2, kb = q / 2, nb = q % 2;
            tr_item((kv ? p.in[6] : p.in[4]) + (size_t)l * 128 * 64, 64, 32 * nb, (h16*)(ws + WS_WC2T) + (size_t)lk * 64 * 128, 128, 32 * nb, 64 * kb, scr, lane); continue; }
        r -= N_C2;
        {
            const int lk = r >> 5, l = lk >> 1, kv = lk & 1, c = r & 31;
            const float* w1 = (kv ? p.in[5] : p.in[3]) + (size_t)l * 2048 * 128; const float* pos = p.in[2] + (size_t)l * 2048;
            float a0 = 0.f, a1 = 0.f;
#pragma unroll 8
            for (int ii = 0; ii < 64; ++ii) { const int i = c * 64 + ii; const float pv = pos[i]; a0 += pv * w1[(size_t)i * 128 + lane]; a1 += pv * w1[(size_t)i * 128 + 64 + lane]; }
            float* o = (float*)(ws + WS_PBP) + ((size_t)lk * 32 + c) * 128; o[lane] = a0; o[64 + lane] = a1;
        }
    }
    const float* x = p.in[0]; h16* xh = (h16*)(ws + WS_XH);
    const size_t nvec = (size_t)MTOK * DM / 8;
    for (size_t i = (size_t)blockIdx.x * 512 + tid; i < nvec; i += (size_t)gridDim.x * 512) {
        const f32x4 a = *(const f32x4*)(x + i * 8), b = *(const f32x4*)(x + i * 8 + 4);
        u32x4 o; o.x = pk2h(a[0], a[1]); o.y = pk2h(a[2], a[3]); o.z = pk2h(b[0], b[1]); o.w = pk2h(b[2], b[3]);
        *(u32x4*)(xh + i * 8) = o;
    }
}

__device__ __forceinline__ void ln_phase(const Params& p, int layer, int wv) {
    PHASE_IDS();
    const float* Y = (const float*)(ws + WS_H); const float* g = p.in[10] + (size_t)layer * DM; const float* bb = p.in[11] + (size_t)layer * DM; float* xout = p.out; h16* xh = (h16*)(ws + WS_XH);
    const int gw = blockIdx.x * 8 + wave, NGW = gridDim.x * 8;
    f32x4 gv[4], bv[4];
#pragma unroll
    for (int j = 0; j < 4; ++j) { gv[j] = *((const f32x4*)g + lane + 64 * j); bv[j] = *((const f32x4*)bb + lane + 64 * j); }
    constexpr int RB = 4;
    for (int m0 = gw * RB; m0 < MTOK; m0 += NGW * RB) {
        f32x4 v[RB][4]; float s[RB];
#pragma unroll
        for (int q = 0; q < RB; ++q) { const f32x4* yr = (const f32x4*)(Y + (size_t)(m0 + q) * DM) + lane; s[q] = 0.f;
#pragma unroll
            for (int j = 0; j < 4; ++j) { v[q][j] = yr[64 * j]; s[q] += (v[q][j][0] + v[q][j][1]) + (v[q][j][2] + v[q][j][3]); } }
#pragma unroll
        for (int o = 1; o < 64; o <<= 1) {
#pragma unroll
            for (int q = 0; q < RB; ++q) s[q] += __shfl_xor(s[q], o); }
        float s2[RB];
#pragma unroll
        for (int q = 0; q < RB; ++q) { const float mean = s[q] * (1.f / DM); s2[q] = 0.f;
#pragma unroll
            for (int j = 0; j < 4; ++j) { v[q][j] = v[q][j] - mean; s2[q] += (v[q][j][0] * v[q][j][0] + v[q][j][1] * v[q][j][1]) + (v[q][j][2] * v[q][j][2] + v[q][j][3] * v[q][j][3]); } }
#pragma unroll
        for (int o = 1; o < 64; o <<= 1) {
#pragma unroll
            for (int q = 0; q < RB; ++q) s2[q] += __shfl_xor(s2[q], o); }
#pragma unroll
        for (int q = 0; q < RB; ++q) { const float rstd = 1.f / sqrtf(s2[q] * (1.f / DM) + 1e-5f);
            f32x4* orow = (f32x4*)(xout + (size_t)(m0 + q) * DM) + lane; u32x2* hrow = (u32x2*)(xh + (size_t)(m0 + q) * DM) + lane;
#pragma unroll
            for (int j = 0; j < 4; ++j) { const f32x4 o = v[q][j] * rstd * gv[j] + bv[j]; orow[64 * j] = o; u32x2 w; w.x = pk2h(o[0], o[1]); w.y = pk2h(o[2], o[3]); hrow[64 * j] = w; } }
    }
}

__device__ __forceinline__ float gelu_tanh(float x) {
    const float y = 0.7978845608028654f * (x + 0.044715f * x * x * x);
    const float t = 1.f - 2.f / (1.f + __expf(2.f * y));
    return 0.5f * x * (1.f + t);
}
__device__ __forceinline__ void compress_unit(const Params& p, int layer, int cu, LAS unsigned char* lds, int wv) {
    PHASE_IDS();
    const int nt = cu & 7, kv = (cu >> 3) & 1, g = (cu >> 4) & 1, b = cu >> 5, lk = layer * 2 + kv;
    const h16* H = (const h16*)(ws + WS_H);
    const h16* W1T = (const h16*)(ws + WS_WC1T) + (size_t)lk * 128 * 2048;
    const h16* W2T = (const h16*)(ws + WS_WC2T) + (size_t)lk * 64 * 128;
    const float* PBP = (const float*)(ws + WS_PBP) + (size_t)lk * 32 * 128;
    LAS h16* hid = (LAS h16*)lds;
    const int fr = lane & 15, kq = lane >> 4;
    const int colbase = (kv ? C_VC : C_KC) + g * 64;
    const int j0 = 16 * wave;
    f32x4 acc[2] = {{0.f, 0.f, 0.f, 0.f}, {0.f, 0.f, 0.f, 0.f}};
    const h16* bptr = W1T + (size_t)(j0 + fr) * 2048 + 8 * kq;
    const int n_a0 = 32 * nt + fr, n_a1 = n_a0 + 16;
#pragma unroll 8
    for (int ks = 0; ks < 64; ++ks) {
        const int pp = ks >> 1, dd = 32 * (ks & 1) + 8 * kq;
        int tok0 = 16 * n_a0 + pp; tok0 = tok0 > SEQ - 1 ? SEQ - 1 : tok0;
        int tok1 = 16 * n_a1 + pp; tok1 = tok1 > SEQ - 1 ? SEQ - 1 : tok1;
        const h16x8 a0 = *(const h16x8*)(H + (size_t)(b * SEQ + tok0) * NH + colbase + dd);
        const h16x8 a1 = *(const h16x8*)(H + (size_t)(b * SEQ + tok1) * NH + colbase + dd);
        const h16x8 bf = *(const h16x8*)(bptr + 32 * ks);
        acc[0] = mfma16(a0, bf, acc[0]); acc[1] = mfma16(a1, bf, acc[1]);
    }
    float bias = 0.f;
#pragma unroll 8
    for (int c = 0; c < 32; ++c) bias += PBP[c * 128 + j0 + fr];
#pragma unroll
    for (int rt = 0; rt < 2; ++rt)
#pragma unroll
        for (int r = 0; r < 4; ++r) hid[(16 * rt + 4 * kq + r) * 136 + j0 + fr] = (h16)gelu_tanh(acc[rt][r] + bias);
    __syncthreads();
    {
        const int rt = wave >> 2, dt = wave & 3;
        f32x4 o = {0.f, 0.f, 0.f, 0.f};
#pragma unroll
        for (int ks = 0; ks < 4; ++ks) {
            const h16x8 a = *(const LAS h16x8*)(hid + (16 * rt + fr) * 136 + 32 * ks + 8 * kq);
            const h16x8 bf = *(const h16x8*)(W2T + (size_t)(16 * dt + fr) * 128 + 32 * ks + 8 * kq);
            o = mfma16(a, bf, o);
        }
        const int d = 16 * dt + fr, n0 = 32 * nt + 16 * rt + 4 * kq;
        if (kv == 0) { h16* KC = (h16*)(ws + WS_KC) + (size_t)(b * 2 + g) * 256 * 64;
#pragma unroll
            for (int r = 0; r < 4; ++r) KC[(size_t)(n0 + r) * 64 + d] = (h16)o[r]; }
        else { h16* VC = (h16*)(ws + WS_VCT) + (size_t)(b * 2 + g) * 256 * 64;
#pragma unroll
            for (int r = 0; r < 4; ++r) ((unsigned short*)VC)[(size_t)(n0 + r) * 64 + d] = (unsigned short)(pk2b(o[r], 0.f) & 0xffffu); }
    }
    __syncthreads();
}

constexpr int HGL_QS = 0, HGL_KS = 17408, HGL_BS = 34816, HGL_QT = 52224, HGL_VT = 61440, HGL_ST = 70656, HGL_AT = 79872, HGL_OS = 89088, HGL_TOT = 105728;
__device__ __forceinline__ void hg_prep(const h16* H, int r0, int hd, float lbv, int d, int seg, LAS float* tot, float (&bv)[8], float (&kv)[8], float& blast) {
    float cs = 0.f; const float lbf = fmaxf(lbv, 1e-30f), oml = 1.f - lbv;
#pragma unroll
    for (int i = 0; i < 8; ++i) {
        const float f = (float)H[(size_t)(r0 + 8 * seg + i) * NH + C_HF + hd * 64 + d];
        const float e = __expf(-fabsf(f)), r = 1.f / (1.f + e);
        const float sig = f >= 0.f ? r : e * r, sigm = f >= 0.f ? e * r : r;
        cs += __logf(lbf + oml * sig); bv[i] = cs; kv[i] = oml * sigm;
    }
    tot[seg * 64 + d] = cs;
    __syncthreads();
    float off = 0.f, all = 0.f;
#pragma unroll
    for (int s = 0; s < 8; ++s) { const float v = tot[s * 64 + d]; all += v; off += s < seg ? v : 0.f; }
#pragma unroll
    for (int i = 0; i < 8; ++i) bv[i] += off;
    blast = all;
}
__device__ __forceinline__ float hg_lb(const Params& p, int layer, int idx) {
    if (layer == 0) return 0.f;
    const float a0 = p.in[7][idx], a1 = p.in[7][384 + idx];
    return 1.f / (1.f + __expf(a0 - a1));
}
constexpr int HG3_KT = 0, HG3_VT = 9216, HG3_UT = 18432, HG3_TOT = 35072, HG3_DL = 37120;
__device__ __forceinline__ void hg_state_unit(const Params& p, int layer, int unit, LAS unsigned char* lds, int wv) {
    PHASE_IDS();
    const h16* H = (const h16*)(ws + WS_H);
    float* HGU = (float*)(ws + WS_HGU); float* HGD = (float*)(ws + WS_HGD); float* HGA = (float*)(ws + WS_HGA); float* HGDG = (float*)(ws + WS_HGDG);
    constexpr int NG = NCHUNK / HG_G;
    const int gi = unit % NG, bh = unit / NG, hd = bh % 6, b = bh / 6, c0 = gi * HG_G;
    const int d = tid & 63, seg = tid >> 6, e_own = tid >> 3, d0 = (tid & 7) * 8;
    LAS h16* KT = (LAS h16*)(lds + HG3_KT); LAS h16* VT = (LAS h16*)(lds + HG3_VT); LAS float* UT = (LAS float*)(lds + HG3_UT); LAS float* tot = (LAS float*)(lds + HG3_TOT); LAS float* DL = (LAS float*)(lds + HG3_DL);
    const float lbv = hg_lb(p, layer, hd * 64 + d), lbf = fmaxf(lbv, 1e-30f), oml = 1.f - lbv;
    float S[8], DGa[8];
#pragma unroll
    for (int j = 0; j < 8; ++j) { S[j] = 0.f; DGa[j] = 1.f; }
    h16 fr_[8], vr_[8];
#define HG_LOAD_RAW2(c_) do { const size_t base_ = (size_t)(b * SEQ + 64 * (c_) + 8 * seg) * NH + hd * 64 + d; \
        _Pragma("unroll") for (int i = 0; i < 8; ++i) { fr_[i] = H[base_ + (size_t)i * NH + C_HF]; vr_[i] = H[base_ + (size_t)i * NH + C_HI]; } } while (0)
    HG_LOAD_RAW2(c0);
    for (int c = c0; c < c0 + HG_G; ++c) {
        const size_t uu = (size_t)bh * 64 + c;
        float bl[8], ky[8]; float cs = 0.f;
#pragma unroll
        for (int i = 0; i < 8; ++i) {
            const float f = (float)fr_[i]; const float e = __expf(-fabsf(f)), r = 1.f / (1.f + e);
            const float sig = f >= 0.f ? r : e * r, sigm = f >= 0.f ? e * r : r;
            cs += __logf(lbf + oml * sig); bl[i] = cs; ky[i] = oml * sigm;
        }
        tot[seg * 64 + d] = cs;
        { h16x8 vt;
#pragma unroll
          for (int i = 0; i < 8; ++i) vt[i] = vr_[i];
          *(LAS h16x8*)(VT + d * 72 + 8 * seg) = vt; }
        __syncthreads();
        float pre = 0.f, blast = 0.f;
#pragma unroll
        for (int s2 = 0; s2 < 8; ++s2) { const float v = tot[s2 * 64 + d]; blast += v; pre += s2 < seg ? v : 0.f; }
        { h16x8 kt;
#pragma unroll
          for (int i = 0; i < 8; ++i) kt[i] = (h16)(ky[i] * __expf(blast - (pre + bl[i])));
          *(LAS h16x8*)(KT + d * 72 + 8 * seg) = kt; }
        if (seg == 0) { const float dd = __expf(blast); DL[d] = dd; HGD[uu * 64 + d] = dd; }
        if (c + 1 < c0 + HG_G) HG_LOAD_RAW2(c + 1);
        __syncthreads();
        if (wave < 4) {
            const int et = wave >> 1, dt = wave & 1, r32 = lane & 31, hi = lane >> 5;
            f32x16 acc = {};
#pragma unroll
            for (int ks = 0; ks < 4; ++ks) {
                const h16x8 a = *(const LAS h16x8*)(VT + (32 * et + r32) * 72 + 16 * ks + 8 * hi);
                const h16x8 bf = *(const LAS h16x8*)(KT + (32 * dt + r32) * 72 + 16 * ks + 8 * hi);
                acc = mfma32(a, bf, acc);
            }
#pragma unroll
            for (int r = 0; r < 16; ++r) { const int e = 32 * et + crow(r, hi); HGU[(uu * 64 + e) * 64 + 32 * dt + r32] = acc[r]; UT[e * 65 + 32 * dt + r32] = acc[r]; }
        }
        __syncthreads();
#pragma unroll
        for (int j = 0; j < 8; ++j) { const float dd = DL[d0 + j]; S[j] = dd * S[j] + UT[e_own * 65 + d0 + j]; DGa[j] *= dd; }
    }
#undef HG_LOAD_RAW2
    {
        const size_t gu = (size_t)bh * NG + gi;
        *(f32x4*)(HGA + (gu * 64 + e_own) * 64 + d0) = (f32x4){S[0], S[1], S[2], S[3]}; *(f32x4*)(HGA + (gu * 64 + e_own) * 64 + d0 + 4) = (f32x4){S[4], S[5], S[6], S[7]};
        if (e_own == 0) { *(f32x4*)(HGDG + gu * 64 + d0) = (f32x4){DGa[0], DGa[1], DGa[2], DGa[3]}; *(f32x4*)(HGDG + gu * 64 + d0 + 4) = (f32x4){DGa[4], DGa[5], DGa[6], DGa[7]}; }
    }
    __syncthreads();
}
constexpr int HG2_QH = 0, HG2_KH = 9216, HG2_QD = 18432, HG2_KD = 35840, HG2_VT = 53248, HG2_ST = 62464, HG2_OS = 71680, HG2_TOT = 88320, HG2_G = 90368, HG2_E = 90880;
__device__ __forceinline__ void hg_out_unit(const Params& p, int layer, int unit, LAS unsigned char* lds, int wv) {
    PHASE_IDS();
    const h16* H = (const h16*)(ws + WS_H); h16* MIX = (h16*)(ws + WS_MIX);
    const float* HGU = (const float*)(ws + WS_HGU); const float* HGD = (const float*)(ws + WS_HGD);
    constexpr int NG = NCHUNK / HG_G;
    const int gi = unit % NG, bh = unit / NG, hd = bh % 6, b = bh / 6, c0 = gi * HG_G;
    const int d = tid & 63, seg = tid >> 6, e_own = tid >> 3, d0 = (tid & 7) * 8, I_own = seg >> 1;
    LAS h16* QH = (LAS h16*)(lds + HG2_QH); LAS h16* KH = (LAS h16*)(lds + HG2_KH); LAS float* QD = (LAS float*)(lds + HG2_QD); LAS float* KD = (LAS float*)(lds + HG2_KD);
    LAS h16* VT = (LAS h16*)(lds + HG2_VT); LAS h16* ST = (LAS h16*)(lds + HG2_ST); LAS float* OS = (LAS float*)(lds + HG2_OS); LAS float* tot = (LAS float*)(lds + HG2_TOT);
    LAS h16* GT = (LAS h16*)(lds + HG2_G); LAS h16* ET = (LAS h16*)(lds + HG2_E);
    const float lbv = hg_lb(p, layer, hd * 64 + d), lbf = fmaxf(lbv, 1e-30f), oml = 1.f - lbv;
    const float* nw = p.in[8] + (size_t)layer * 384 + hd * 64;
    float S[8];
#pragma unroll
    for (int j = 0; j < 8; ++j) S[j] = 0.f;
    { const float* HGA = (const float*)(ws + WS_HGA); const float* HGDG = (const float*)(ws + WS_HGDG);
      for (int gg = 0; gg < gi; ++gg) {
        const size_t gu = (size_t)bh * NG + gg;
        const f32x4 D0 = *(const f32x4*)(HGDG + gu * 64 + d0), D1 = *(const f32x4*)(HGDG + gu * 64 + d0 + 4);
        const f32x4 U0 = *(const f32x4*)(HGA + (gu * 64 + e_own) * 64 + d0), U1 = *(const f32x4*)(HGA + (gu * 64 + e_own) * 64 + d0 + 4);
#pragma unroll
        for (int j = 0; j < 4; ++j) { S[j] = D0[j] * S[j] + U0[j]; S[4 + j] = D1[j] * S[4 + j] + U1[j]; }
      } }
    h16 fr_[8], qr_[8], vr_[8];
#define HG_LOAD_RAW(c_) do { const size_t base_ = (size_t)(b * SEQ + 64 * (c_) + 8 * seg) * NH + hd * 64 + d; \
        _Pragma("unroll") for (int i = 0; i < 8; ++i) { fr_[i] = H[base_ + (size_t)i * NH + C_HF]; qr_[i] = H[base_ + (size_t)i * NH + C_HQ]; vr_[i] = H[base_ + (size_t)i * NH + C_HI]; } } while (0)
    HG_LOAD_RAW(c0);
    for (int c = c0; c < c0 + HG_G; ++c) {
        const int r0 = b * SEQ + 64 * c; const size_t uu = (size_t)bh * 64 + c;
        const f32x4 D0 = *(const f32x4*)(HGD + uu * 64 + d0), D1 = *(const f32x4*)(HGD + uu * 64 + d0 + 4);
        const f32x4 U0 = *(const f32x4*)(HGU + (uu * 64 + e_own) * 64 + d0), U1 = *(const f32x4*)(HGU + (uu * 64 + e_own) * 64 + d0 + 4);
        const h16x8 zg = *(const h16x8*)(H + (size_t)(r0 + (tid >> 3)) * NH + C_HZ + hd * 64 + (tid & 7) * 8);
        float bl[8], ky[8], qv[8]; float cs = 0.f;
#pragma unroll
        for (int i = 0; i < 8; ++i) {
            const float f = (float)fr_[i]; const float e = __expf(-fabsf(f)), r = 1.f / (1.f + e);
            const float sig = f >= 0.f ? r : e * r, sigm = f >= 0.f ? e * r : r;
            cs += __logf(lbf + oml * sig); bl[i] = cs; ky[i] = oml * sigm; qv[i] = (float)qr_[i];
        }
        tot[seg * 64 + d] = cs;
        { h16x8 vt;
#pragma unroll
          for (int i = 0; i < 8; ++i) vt[i] = vr_[i];
          *(LAS h16x8*)(VT + d * 72 + 8 * seg) = vt; }
        { h16x8 st;
#pragma unroll
          for (int j = 0; j < 8; ++j) st[j] = (h16)S[j];
          *(LAS h16x8*)(ST + e_own * 72 + d0) = st; }
        __syncthreads();
        float P[9]; P[0] = 0.f;
#pragma unroll
        for (int s2 = 0; s2 < 8; ++s2) P[s2 + 1] = P[s2] + tot[s2 * 64 + d];
        float pre = 0.f, beta = 0.f, betan = 0.f, mu = 0.f;
#pragma unroll
        for (int s2 = 0; s2 < 9; ++s2) { pre = (s2 == seg) ? P[s2] : pre; beta = (s2 == 2 * I_own) ? P[s2] : beta; betan = (s2 == 2 * I_own + 2) ? P[s2] : betan; mu = (s2 == 2 * I_own + 1) ? P[s2] : mu; }
#pragma unroll
        for (int i = 0; i < 8; ++i) {
            const int t = 8 * seg + i; const float bb = pre + bl[i];
            QH[t * 72 + d] = (h16)(qv[i] * __expf(bb - beta)); KH[t * 72 + d] = (h16)(ky[i] * __expf(betan - bb));
            QD[t * 68 + d] = qv[i] * __expf(bb - mu); KD[t * 68 + d] = ky[i] * __expf(mu - bb);
        }
        if (seg == 0) {
            GT[0 * 64 + d] = (h16)__expf(P[4] - P[2]); GT[1 * 64 + d] = (h16)__expf(P[6] - P[4]); GT[2 * 64 + d] = (h16)__expf(P[6] - P[2]);
            ET[0 * 64 + d] = (h16)1.f; ET[1 * 64 + d] = (h16)__expf(P[2]); ET[2 * 64 + d] = (h16)__expf(P[4]); ET[3 * 64 + d] = (h16)__expf(P[6]);
        }
        if (c + 1 < c0 + HG_G) HG_LOAD_RAW(c + 1);
        __syncthreads();
        {
            const int I = wave & 3, eh = wave >> 2, fr = lane & 15, kq = lane >> 4, trow = 16 * I + fr;
            h16x8 qh[2];
#pragma unroll
            for (int ks = 0; ks < 2; ++ks) qh[ks] = *(const LAS h16x8*)(QH + trow * 72 + 32 * ks + 8 * kq);
            f32x4 att[4];
#pragma unroll
            for (int J = 0; J < 4; ++J) att[J] = (f32x4){0.f, 0.f, 0.f, 0.f};
            {
                f32x4 ad = {0.f, 0.f, 0.f, 0.f};
#pragma unroll
                for (int q4 = 0; q4 < 4; ++q4) {
                    const f32x4 ka = *(const LAS f32x4*)(KD + trow * 68 + 16 * kq + 4 * q4), qa = *(const LAS f32x4*)(QD + trow * 68 + 16 * kq + 4 * q4);
#pragma unroll
                    for (int x = 0; x < 4; ++x) ad = __builtin_amdgcn_mfma_f32_16x16x4f32(ka[x], qa[x], ad, 0, 0, 0);
                }
#pragma unroll
                for (int r = 0; r < 4; ++r) ad[r] = (4 * kq + r <= fr) ? ad[r] : 0.f;
#pragma unroll
                for (int J = 0; J < 4; ++J) att[J] = (J == I) ? ad : att[J];
            }
#pragma unroll
            for (int J = 0; J < 3; ++J) {
                if (J < I) {
                    h16x8 kh0 = *(const LAS h16x8*)(KH + (16 * J + fr) * 72 + 8 * kq), kh1 = *(const LAS h16x8*)(KH + (16 * J + fr) * 72 + 32 + 8 * kq);
                    if (I - J >= 2) { const int gi2 = (I == 2) ? 0 : (J == 1 ? 1 : 2);
                        kh0 = kh0 * *(const LAS h16x8*)(GT + gi2 * 64 + 8 * kq); kh1 = kh1 * *(const LAS h16x8*)(GT + gi2 * 64 + 32 + 8 * kq); }
                    f32x4 a = {0.f, 0.f, 0.f, 0.f};
                    a = mfma16(kh0, qh[0], a); a = mfma16(kh1, qh[1], a);
                    att[J] = a;
                }
            }
            const h16x8 pf01 = {(h16)att[0][0], (h16)att[0][1], (h16)att[0][2], (h16)att[0][3], (h16)att[1][0], (h16)att[1][1], (h16)att[1][2], (h16)att[1][3]};
            const h16x8 pf23 = {(h16)att[2][0], (h16)att[2][1], (h16)att[2][2], (h16)att[2][3], (h16)att[3][0], (h16)att[3][1], (h16)att[3][2], (h16)att[3][3]};
            const h16x8 qe0 = qh[0] * *(const LAS h16x8*)(ET + I * 64 + 8 * kq), qe1 = qh[1] * *(const LAS h16x8*)(ET + I * 64 + 32 + 8 * kq);
#pragma unroll
            for (int e2 = 0; e2 < 2; ++e2) {
                const int et = 2 * eh + e2, erow = 16 * et + fr;
                f32x4 o = {0.f, 0.f, 0.f, 0.f};
                { const h16x4 v0 = *(const LAS h16x4*)(VT + erow * 72 + 4 * kq), v1 = *(const LAS h16x4*)(VT + erow * 72 + 16 + 4 * kq);
                  o = mfma16((h16x8){v0[0], v0[1], v0[2], v0[3], v1[0], v1[1], v1[2], v1[3]}, pf01, o); }
                if (I >= 2) { const h16x4 v0 = *(const LAS h16x4*)(VT + erow * 72 + 32 + 4 * kq), v1 = *(const LAS h16x4*)(VT + erow * 72 + 48 + 4 * kq);
                  o = mfma16((h16x8){v0[0], v0[1], v0[2], v0[3], v1[0], v1[1], v1[2], v1[3]}, pf23, o); }
                o = mfma16(*(const LAS h16x8*)(ST + erow * 72 + 8 * kq), qe0, o);
                o = mfma16(*(const LAS h16x8*)(ST + erow * 72 + 32 + 8 * kq), qe1, o);
#pragma unroll
                for (int r = 0; r < 4; ++r) OS[trow * 65 + 16 * et + 4 * kq + r] = o[r];
            }
        }
#pragma unroll
        for (int j = 0; j < 4; ++j) { S[j] = D0[j] * S[j] + U0[j]; S[4 + j] = D1[j] * S[4 + j] + U1[j]; }
        __syncthreads();
        {
            const int t = tid >> 3, e0 = (tid & 7) * 8;
            float o[8], ssq = 0.f;
#pragma unroll
            for (int j = 0; j < 8; ++j) { o[j] = OS[t * 65 + e0 + j]; ssq += o[j] * o[j]; }
            ssq += __shfl_xor(ssq, 1); ssq += __shfl_xor(ssq, 2); ssq += __shfl_xor(ssq, 4);
            const float rinv = 1.f / sqrtf(ssq * (1.f / 64.f) + 1e-6f);
            const f32x4 w0 = *(const f32x4*)(nw + e0), w1 = *(const f32x4*)(nw + e0 + 4);
            h16x8 ov;
#pragma unroll
            for (int j = 0; j < 8; ++j) { const float zz = (float)zg[j]; const float w = j < 4 ? w0[j & 3] : w1[j & 3];
                ov[j] = (h16)(o[j] * rinv * w * (zz / (1.f + __expf(-zz)))); }
            *(h16x8*)(MIX + (size_t)(r0 + t) * DM + 640 + hd * 64 + e0) = ov;
        }
    }
#undef HG_LOAD_RAW
    __syncthreads();
}

constexpr int REP_P0 = 1, REP_P1 = 1, REP_P4 = 1, REP_P5 = 1, REP_P2 = 1, REP_NSA = 1, REP_SB = 1, REP_HG = 1;
constexpr int LDS_BYTES = 147456;
__global__ void __launch_bounds__(512, 2) mega(Params p) {
    extern __shared__ __attribute__((aligned(16))) unsigned char lds_raw[];
    LAS unsigned char* lds = (LAS unsigned char*)lds_raw;
    cg::grid_group grid = cg::this_grid();
    const int wv = __builtin_amdgcn_readfirstlane(threadIdx.x >> 6);
    { LAS unsigned* misc = (LAS unsigned*)(lds + LDS_BYTES - 64); if (threadIdx.x < 16) misc[threadIdx.x] = 0u; }
    __syncthreads();
    XcdBarrier xbar = xcd_barrier_post((unsigned*)(p.ws + WS_CTL), (volatile LAS unsigned*)(lds + LDS_BYTES - 64));
#define GRID_BAR() xcd_barrier(xbar, wv)

    for (int rep = 0; rep < REP_P0; ++rep) prologue(p, lds, wv);
    grid.sync();
    for (int layer = 0; layer < DEPTH; ++layer) {
        {
            unsigned char* ws = p.ws; asm volatile("" : "+s"(ws)); h16* XH = (h16*)(ws + WS_XH); h16* Hb = (h16*)(ws + WS_H);
            pg8::Gemm g{(const pg8::bf16_t*)XH, (const pg8::bf16_t*)((h16*)(ws + WS_WINT) + (size_t)layer * NH * 1024), MTOK, NH, DM};
            pg8::StaticOrder S; S.init(MTOK, NH, gridDim.x, blockIdx.x);
            pg8::EpiH E{Hb, NH};
            for (int rep = 0; rep < REP_P1; ++rep) pg8::gemm_phase<pg8::EpiH, pg8::StaticOrder, true, true>(lds, g, S, E, wv);
        }
        GRID_BAR();
        for (int rep = 0; rep < REP_P2; ++rep)
        {
            constexpr int N_HG = 48 * (NCHUNK / HG_G), N_UNITS = N_HG + 256;
            unsigned* ctr = (unsigned*)(p.ws + WS_CTL + 32768) + 64 * (2 + layer);
            LAS int* qslot = (LAS int*)(lds + LDS_BYTES - 128);
            for (;;) {
                if (wv == 0 && __builtin_amdgcn_mbcnt_hi(~0u, __builtin_amdgcn_mbcnt_lo(~0u, 0u)) == 0) qslot[0] = (int)__hip_atomic_fetch_add(ctr, 1u, __ATOMIC_RELAXED, __HIP_MEMORY_SCOPE_AGENT);
                __syncthreads();
                const int u = qslot[0];
                __syncthreads();
                if (u >= N_UNITS) break;
                if (u < N_HG) hg_state_unit(p, layer, u, lds, wv);
                else compress_unit(p, layer, u - N_HG, lds, wv);
            }
        }
        GRID_BAR();
        {
            constexpr int N_HG = 48 * (NCHUNK / HG_G), N_UNITS = 512 + N_HG + 512;
            unsigned* ctr = (unsigned*)(p.ws + WS_CTL + 32768) + 64 * layer;
            LAS int* qslot = (LAS int*)(lds + LDS_BYTES - 128);
            for (;;) {
                if (wv == 0 && __builtin_amdgcn_mbcnt_hi(~0u, __builtin_amdgcn_mbcnt_lo(~0u, 0u)) == 0) qslot[0] = (int)__hip_atomic_fetch_add(ctr, 1u, __ATOMIC_RELAXED, __HIP_MEMORY_SCOPE_AGENT);
                __syncthreads();
                const int u = qslot[0];
                __syncthreads();
                if (u >= N_UNITS) break;
                if (u < 512) { for (int rep = 0; rep < REP_NSA; ++rep) nsa_unit(p, u, lds, wv); }
                else if (u < 512 + N_HG) { for (int rep = 0; rep < REP_HG; ++rep) hg_out_unit(p, layer, u - 512, lds, wv); }
                else { for (int rep = 0; rep < REP_SB; ++rep) sb_unit(p, u - 512 - N_HG, lds, wv); }
            }
        }
        GRID_BAR();
        {
            unsigned char* ws = p.ws; asm volatile("" : "+s"(ws)); h16* MIX = (h16*)(ws + WS_MIX); float* Y = (float*)(ws + WS_H);
            pg8::Gemm g{(const pg8::bf16_t*)MIX, (const pg8::bf16_t*)((h16*)(ws + WS_WOUTT) + (size_t)layer * 1024 * 1024), MTOK, DM, DM};
            pg8::StaticOrder S; S.init(MTOK, DM, gridDim.x, blockIdx.x);
            pg8::EpiY E{layer == 0 ? p.in[0] : p.out, Y, ALPHA};
            for (int rep = 0; rep < REP_P4; ++rep) pg8::gemm_phase<pg8::EpiY, pg8::StaticOrder, true, true>(lds, g, S, E, wv);
        }
        GRID_BAR();
        for (int rep = 0; rep < REP_P5; ++rep) ln_phase(p, layer, wv);
        if (layer + 1 < DEPTH) GRID_BAR();
    }
}

extern "C" void kernel_launch(void* const* d_in, const int* in_sizes, int n_in, void* d_out, int out_size, void* d_ws, size_t ws_size, hipStream_t stream) {
    static int grid = 0;
    if (grid == 0) {
        if (n_in != 13 || ws_size < WS_END) { fprintf(stderr, "kernel_launch: unexpected n_in %d or ws_size %zu (< %zu)\n", n_in, ws_size, (size_t)WS_END); grid = -1; return; }
        int dev = 0, cus = 0, per_cu = 0;
        hipGetDevice(&dev); hipDeviceGetAttribute(&cus, hipDeviceAttributeMultiprocessorCount, dev);
        if (hipFuncSetAttribute((const void*)mega, hipFuncAttributeMaxDynamicSharedMemorySize, LDS_BYTES) != hipSuccess) { fprintf(stderr, "kernel_launch: hipFuncSetAttribute failed\n"); grid = -1; return; }
        if (hipOccupancyMaxActiveBlocksPerMultiprocessor(&per_cu, (const void*)mega, 512, LDS_BYTES) != hipSuccess || per_cu < 1) { fprintf(stderr, "kernel_launch: occupancy query failed (%d)\n", per_cu); (void)hipGetLastError(); per_cu = 1; }
        grid = cus * per_cu;
        fprintf(stderr, "kernel_launch: cus %d per_cu %d grid %d\n", cus, per_cu, grid);
    }
    if (grid < 0) return;
    hipMemsetAsync((char*)d_ws + WS_CTL, 0, CTL_BYTES, stream);
    Params p{};
    for (int i = 0; i < 13; ++i) p.in[i] = (const float*)d_in[i];
    p.out = (float*)d_out; p.ws = (unsigned char*)d_ws;
    void* args[] = {&p};
    hipError_t e = hipLaunchCooperativeKernel((const void*)mega, dim3(grid), dim3(512), args, LDS_BYTES, stream);
    if (e != hipSuccess) fprintf(stderr, "cooperative launch failed: %s (grid %d)\n", hipGetErrorString(e), grid);
}
```

```cpp
#include <hip/hip_runtime.h>
#include <hip/hip_cooperative_groups.h>
#include <cstdio>
#include <cstdint>
namespace cg = cooperative_groups;

#define LAS __attribute__((address_space(3)))
typedef _Float16 h16;
typedef _Float16 h16x8 __attribute__((ext_vector_type(8)));
typedef _Float16 h16x4 __attribute__((ext_vector_type(4)));
typedef _Float16 h16x2 __attribute__((ext_vector_type(2)));
typedef short s16x4 __attribute__((ext_vector_type(4)));
typedef float f32x2 __attribute__((ext_vector_type(2)));
typedef float f32x4 __attribute__((ext_vector_type(4)));
typedef unsigned u32x4 __attribute__((ext_vector_type(4)));
typedef float f32x16 __attribute__((ext_vector_type(16)));
typedef unsigned u32x2 __attribute__((ext_vector_type(2)));

constexpr int NB = 8, SEQ = 4096, DM = 1024, MTOK = NB * SEQ, DEPTH = 2;
constexpr int DIN = 4114, NH = 4352;
constexpr int C_NQ = 0, C_KC = 384, C_VC = 512, C_KS = 640, C_VS = 768, C_KW = 896, C_VW = 1024, C_NZ = 1152;
constexpr int C_SQ = 1536, C_SK = 1792, C_SV = 2048, C_SZ = 2304, C_HQ = 2560, C_HF = 2944, C_HI = 3328, C_HZ = 3712, C_G = 4096;
#define HCOL(H, col) ((H) + (size_t)((col) >> 6) * ((size_t)MTOK * 64) + ((col) & 63))
constexpr float ALPHA = 1.4142135623730951f;
constexpr int NCHUNK = 64;
constexpr int HG_G = 8;

constexpr size_t MiB = 1u << 20;
constexpr size_t WS_CTL = 0;
constexpr size_t CTL_BYTES = 65536;
constexpr size_t WS_WINT = 2 * MiB;
constexpr size_t WS_WOUTT = 20 * MiB;
constexpr size_t WS_WC1T = 24 * MiB;
constexpr size_t WS_WC2T = 26 * MiB;
constexpr size_t WS_PBP = 26 * MiB + 512 * 1024;
constexpr size_t WS_KC = 27 * MiB;
constexpr size_t WS_VCT = 27 * MiB + 512 * 1024;
constexpr size_t WS_HGU = 28 * MiB;
constexpr size_t WS_HGD = 79 * MiB;
constexpr size_t WS_XH = 80 * MiB;
constexpr size_t WS_MIX = 144 * MiB;
constexpr size_t WS_H = 208 * MiB;
constexpr size_t WS_HGA = 480 * MiB;
constexpr size_t WS_HGDG = 494 * MiB;
constexpr size_t WS_STAT = 495 * MiB;
constexpr size_t WS_XB = 496 * MiB;
constexpr size_t WS_END = 497 * MiB;

struct Params { const float* in[13]; float* out; unsigned char* ws; };

__device__ __forceinline__ unsigned pk2h(float a, float b) { h16x2 v = {(h16)a, (h16)b}; return __builtin_bit_cast(unsigned, v); }
typedef __bf16 bf16x2_t __attribute__((ext_vector_type(2)));
__device__ __forceinline__ unsigned pk2b(float lo, float hi) { const f32x2 v = {lo, hi}; return __builtin_bit_cast(unsigned, __builtin_convertvector(v, bf16x2_t)); }
__device__ __forceinline__ float wave_sum(float v) {
#pragma unroll
    for (int o = 1; o < 64; o <<= 1) v += __shfl_xor(v, o);
    return v;
}
__device__ __forceinline__ float xhalf(float x, int hi) {
    auto r = __builtin_amdgcn_permlane32_swap(__float_as_uint(x), __float_as_uint(x), false, false);
    return __uint_as_float(hi ? r[0] : r[1]);
}
__device__ __forceinline__ f32x16 mfma32(h16x8 a, h16x8 b, f32x16 c) { return __builtin_amdgcn_mfma_f32_32x32x16_f16(a, b, c, 0, 0, 0); }
__device__ __forceinline__ f32x4 mfma16(h16x8 a, h16x8 b, f32x4 c) { return __builtin_amdgcn_mfma_f32_16x16x32_f16(a, b, c, 0, 0, 0); }
__device__ __forceinline__ int crow(int r, int hi) { return (r & 3) + 8 * (r >> 2) + 4 * hi; }
namespace pg8 {
#define PG8_LAS __attribute__((address_space(3)))
typedef unsigned short bf16_t;
typedef short bf16x8 __attribute__((ext_vector_type(8)));
typedef float f32x4 __attribute__((ext_vector_type(4)));
typedef unsigned u32x4 __attribute__((ext_vector_type(4)));
constexpr int BM = 256, BK = 64, HALF = 128, HTB = HALF * BK * 2  , STAGE_BYTES = 8 * HTB, NXCD = 8, WGM = 8;

__host__ __device__ __forceinline__ int lds_byte(int r, int c) { const int st = (r >> 4) * 2 + (c >> 5), rr = r & 15, cc = c & 31, ob = rr * 64 + cc * 2; return st * 1024 + (ob ^ (((ob >> 9) & 1) << 5)); }
__host__ __device__ __forceinline__ void stage_rc(int b, int& R, int& C) { const int st = b / 1024, sb = b % 1024, swz = sb ^ (((sb >> 9) & 1) << 5); R = (st >> 1) * 16 + swz / 64; C = (st & 1) * 32 + (swz % 64) / 2; }
__host__ __device__ __forceinline__ int perm32(int rho) { const int n = rho >> 4, i = rho & 15; return 8 * (i >> 2) + 4 * n + (i & 3); }

struct Unit { int pm, pn; };
struct Gemm { const bf16_t* A; const bf16_t* Bt; int M, N, K; };

struct StaticOrder {
    int nM, nN, nwg, G, c;
    __host__ __device__ void init(int M, int N, int G_, int c_) { nM = M / BM; nN = N / BM; nwg = nM * nN; G = G_; c = c_; }
    __host__ __device__ bool next(int i, Unit& u) const {
        const long L = (long)i * G + c; if (L >= nwg) return false;
        int wgid = (int)L; { const int q = nwg / NXCD, r = nwg % NXCD, xcd = wgid % NXCD, off = wgid / NXCD; wgid = (xcd < r ? xcd * (q + 1) : r * (q + 1) + (xcd - r) * q) + off; }
        const int nig = WGM * nN, gid = wgid / nig, fm = gid * WGM, gsz = (nM - fm) < WGM ? (nM - fm) : WGM;
        u.pm = fm + ((wgid % nig) % gsz); u.pn = (wgid % nig) / gsz; return true;
    }
    __device__ __forceinline__ void a_ready(const Unit&) const {}
    __device__ __forceinline__ void done(const Unit&) const {}
};

struct EpiH {
    static constexpr bool PERM = true, AFTER_DRAIN = false;
    _Float16* O; int M;
    __device__ __forceinline__ void operator()(const f32x4 (&acc)[2][2][4][2], const Unit& u, int wr, int wc, int fr, int fq) const {
        const int row0 = u.pm * BM + wr * 64 + fr; const int col0 = u.pn * BM + wc * 32 + 8 * fq;
#pragma unroll
        for (int bj = 0; bj < 2; ++bj) { const int col = col0 + bj * HALF; _Float16* gp = O + (size_t)(col >> 6) * ((size_t)M * 64) + (col & 63);
#pragma unroll
            for (int ai = 0; ai < 2; ++ai)
#pragma unroll
                for (int m = 0; m < 4; ++m) { const f32x4 v0 = acc[ai][bj][m][0], v1 = acc[ai][bj][m][1];
                    u32x4 w;
                    if (bj == 0 && (u.pn == 3 || u.pn == 4)) { w.x = pk2b(v0[0], v0[1]); w.y = pk2b(v0[2], v0[3]); w.z = pk2b(v1[0], v1[1]); w.w = pk2b(v1[2], v1[3]); }
                    else { w.x = pk2h(v0[0], v0[1]); w.y = pk2h(v0[2], v0[3]); w.z = pk2h(v1[0], v1[1]); w.w = pk2h(v1[2], v1[3]); }
                    *(u32x4*)(gp + (size_t)(row0 + ai * HALF + m * 16) * 64) = w; } }
    }
};
template <bool BASE16> struct EpiY {
    static constexpr bool PERM = false, AFTER_DRAIN = false;
    const void* base; _Float16* out; float alpha;
    __device__ __forceinline__ void operator()(const f32x4 (&acc)[2][2][4][2], const Unit& u, int wr, int wc, int fr, int fq) const {
        const int col0 = u.pn * BM + wc * 32 + 4 * fq;
#pragma unroll
        for (int ai = 0; ai < 2; ++ai)
#pragma unroll
            for (int m = 0; m < 4; ++m) { const int r = u.pm * BM + ai * HALF + wr * 64 + m * 16 + fr; const size_t off = (size_t)r * 1024 + col0;
#pragma unroll
                for (int bj = 0; bj < 2; ++bj)
#pragma unroll
                    for (int n = 0; n < 2; ++n) { f32x4 bs;
                        if (BASE16) { const h16x4 b4 = *(const h16x4*)((const _Float16*)base + off + bj * HALF + n * 16); bs = (f32x4){(float)b4[0], (float)b4[1], (float)b4[2], (float)b4[3]}; }
                        else bs = *(const f32x4*)((const float*)base + off + bj * HALF + n * 16);
                        const f32x4 o = acc[ai][bj][m][n] + bs * alpha; u32x2 w; w.x = pk2h(o[0], o[1]); w.y = pk2h(o[2], o[3]);
                        *(u32x2*)(out + off + bj * HALF + n * 16) = w; } }
    }
};
template <class Epi, class Sched, bool ALIGN_EPI = false, bool SP2 = false>
__device__ __forceinline__ void gemm_phase(PG8_LAS unsigned char* lds, const Gemm g, const Sched& S, const Epi& E, int wv) {
    int lane0_ = __builtin_amdgcn_mbcnt_hi(~0u, __builtin_amdgcn_mbcnt_lo(~0u, 0u)); asm volatile("" : "+v"(lane0_)); const int tid_ = wv * 64 + lane0_;
    const int tid = tid_, wid = __builtin_amdgcn_readfirstlane(tid >> 6), lane = tid & 63, wr = wid >> 2, wc = wid & 3, fr = lane & 15, fq = lane >> 4;
    const int K = g.K, nt = K / BK;
    unsigned voffA[2], voffB[2];
#pragma unroll
    for (int i = 0; i < 2; ++i) { int R, C; stage_rc(tid * 16 + i * 8192, R, C); const int Rb = Epi::PERM ? ((R & ~31) + perm32(R & 31)) : R;
        voffA[i] = (unsigned)(R * K + C) * 2u; voffB[i] = (unsigned)(Rb * K + C) * 2u; }
    const size_t kstep = (size_t)(BK * 2);
    const size_t hstep = (size_t)HALF * K * 2;
    const size_t tstep = 2 * hstep;
    const unsigned ldsw = (unsigned)wid * 1024u;
    const int aoff = lds_byte(wr * 64 + fr, fq * 8), boff = lds_byte(wc * 32 + fr, fq * 8);
#define PG8_SA(b, h) (((b) * 2 + (h)) * HTB)
#define PG8_SB(b, h) ((4 + (b) * 2 + (h)) * HTB)
#define PG8_STAGE(bufoff, gbase, voff) do { _Pragma("unroll") for (int _i = 0; _i < 2; ++_i) \
        __builtin_amdgcn_global_load_lds((const unsigned*)((const char*)(gbase) + (voff)[_i]), (PG8_LAS unsigned*)(lds + (bufoff) + ldsw + _i * 8192), 16, 0, 0); } while (0)
#define PG8_LDA(dst, b, h) do { _Pragma("unroll") for (int m = 0; m < 4; ++m) _Pragma("unroll") for (int k = 0; k < 2; ++k) dst[m][k] = *(const PG8_LAS bf16x8*)(lds + PG8_SA(b, h) + aoff + m * 2048 + k * 1024); } while (0)
#define PG8_LDB(dst, b, h) do { _Pragma("unroll") for (int n = 0; n < 2; ++n) _Pragma("unroll") for (int k = 0; k < 2; ++k) dst[n][k] = *(const PG8_LAS bf16x8*)(lds + PG8_SB(b, h) + boff + n * 2048 + k * 1024); } while (0)
#define PG8_MMA(ai, bj, At, Bt) do { __builtin_amdgcn_s_setprio(1); _Pragma("unroll") for (int m = 0; m < 4; ++m) _Pragma("unroll") for (int n = 0; n < 2; ++n) _Pragma("unroll") for (int k = 0; k < 2; ++k) \
        acc[ai][bj][m][n] = __builtin_amdgcn_mfma_f32_16x16x32_f16(__builtin_bit_cast(h16x8, Bt[n][k]), __builtin_bit_cast(h16x8, At[m][k]), acc[ai][bj][m][n], 0, 0, 0); __builtin_amdgcn_s_setprio(0); } while (0)
#define PG8_WAIT_V(n) asm volatile("s_waitcnt vmcnt(" #n ")" ::: "memory")
#define PG8_WAIT_L(n) asm volatile("s_waitcnt lgkmcnt(" #n ")" ::: "memory")
#define PG8_BAR __builtin_amdgcn_s_barrier()
#define PG8_SCHED __builtin_amdgcn_sched_barrier(0)
    Unit cur, nxt; int ui = 0;
    if (!S.next(0, cur)) return;
    f32x4 acc[2][2][4][2];
#pragma unroll
    for (int a = 0; a < 2; ++a)
#pragma unroll
        for (int b = 0; b < 2; ++b)
#pragma unroll
            for (int m = 0; m < 4; ++m)
#pragma unroll
                for (int n = 0; n < 2; ++n) acc[a][b][m][n] = (f32x4){0.f, 0.f, 0.f, 0.f};
    bf16x8 At[4][2], B0[2][2], B1[2][2];
    const char* cA = (const char*)g.A + (size_t)cur.pm * tstep; const char* cB = (const char*)g.Bt + (size_t)cur.pn * tstep;
    S.a_ready(cur);
    if constexpr (SP2) {
        PG8_STAGE(PG8_SB(0, 0), cB, voffB); PG8_STAGE(PG8_SB(0, 1), cB + hstep, voffB); PG8_STAGE(PG8_SA(0, 0), cA, voffA); PG8_STAGE(PG8_SA(0, 1), cA + hstep, voffA);
        if (wr == 1) PG8_BAR;
        PG8_WAIT_V(2); PG8_BAR;
        PG8_STAGE(PG8_SB(1, 0), cB + kstep, voffB); PG8_STAGE(PG8_SA(1, 0), cA + kstep, voffA); PG8_STAGE(PG8_SB(1, 1), cB + hstep + kstep, voffB);
        PG8_WAIT_V(6); PG8_BAR;
    } else {
        PG8_STAGE(PG8_SB(0, 0), cB, voffB); PG8_STAGE(PG8_SA(0, 0), cA, voffA); PG8_STAGE(PG8_SB(0, 1), cB + hstep, voffB); PG8_STAGE(PG8_SA(0, 1), cA + hstep, voffA);
        if (wr == 1) PG8_BAR;
        PG8_WAIT_V(4); PG8_BAR;
        PG8_STAGE(PG8_SB(1, 0), cB + kstep, voffB); PG8_STAGE(PG8_SA(1, 0), cA + kstep, voffA); PG8_STAGE(PG8_SB(1, 1), cB + hstep + kstep, voffB);
        PG8_WAIT_V(6); PG8_BAR;
    }
    for (;;) {
        const bool has_next = S.next(ui + 1, nxt);
        const char* nA = has_next ? (const char*)g.A + (size_t)nxt.pm * tstep : cA; const char* nB = has_next ? (const char*)g.Bt + (size_t)nxt.pn * tstep : cB;
        for (int t = 0; t < nt; t += 2) {
            const bool last = (t == nt - 2);
            const char* a1 = cA + (size_t)(t + 1) * kstep;
            const char* a2 = last ? nA : cA + (size_t)(t + 2) * kstep; const char* b2 = last ? nB : cB + (size_t)(t + 2) * kstep;
            const char* a3 = a2 + kstep; const char* b3 = b2 + kstep;
            if (last && has_next) S.a_ready(nxt);
            if constexpr (SP2) {
            PG8_LDB(B0, 0, 0); PG8_LDB(B1, 0, 1); PG8_SCHED; PG8_LDA(At, 0, 0); PG8_STAGE(PG8_SA(1, 1), a1 + hstep, voffA);
            PG8_WAIT_V(8); PG8_WAIT_L(0); PG8_BAR; PG8_MMA(0, 0, At, B0); PG8_MMA(0, 1, At, B1); PG8_BAR; PG8_SCHED;
            PG8_LDA(At, 0, 1); PG8_STAGE(PG8_SB(0, 0), b2, voffB); PG8_STAGE(PG8_SB(0, 1), b2 + hstep, voffB); PG8_STAGE(PG8_SA(0, 0), a2, voffA);
            PG8_WAIT_V(8); PG8_WAIT_L(0); PG8_BAR; PG8_MMA(1, 0, At, B0); PG8_MMA(1, 1, At, B1); PG8_BAR; PG8_SCHED;
            PG8_LDB(B0, 1, 0); PG8_LDB(B1, 1, 1); PG8_SCHED; PG8_LDA(At, 1, 0); PG8_STAGE(PG8_SA(0, 1), a2 + hstep, voffA);
            PG8_WAIT_V(8); PG8_WAIT_L(0); PG8_BAR; PG8_MMA(0, 0, At, B0); PG8_MMA(0, 1, At, B1); PG8_BAR; PG8_SCHED;
            PG8_LDA(At, 1, 1); PG8_STAGE(PG8_SB(1, 0), b3, voffB); PG8_STAGE(PG8_SB(1, 1), b3 + hstep, voffB); PG8_STAGE(PG8_SA(1, 0), a3, voffA);
            PG8_WAIT_V(8); PG8_WAIT_L(0); PG8_BAR; PG8_MMA(1, 0, At, B0); PG8_MMA(1, 1, At, B1); PG8_BAR; PG8_SCHED;
            } else {
            PG8_LDB(B0, 0, 0); PG8_SCHED; PG8_LDA(At, 0, 0); PG8_STAGE(PG8_SA(1, 1), a1 + hstep, voffA);
            PG8_WAIT_L(8); PG8_BAR; PG8_WAIT_L(0); PG8_MMA(0, 0, At, B0); PG8_BAR; PG8_SCHED;
            PG8_LDB(B1, 0, 1); PG8_STAGE(PG8_SB(0, 0), b2, voffB);
            PG8_BAR; PG8_WAIT_L(0); PG8_MMA(0, 1, At, B1); PG8_BAR;
            PG8_LDA(At, 0, 1); PG8_STAGE(PG8_SA(0, 0), a2, voffA);
            PG8_BAR; PG8_WAIT_L(0); PG8_MMA(1, 0, At, B0); PG8_BAR; PG8_SCHED;
            PG8_STAGE(PG8_SB(0, 1), b2 + hstep, voffB);
            PG8_WAIT_V(6); PG8_BAR; PG8_MMA(1, 1, At, B1); PG8_BAR;
            PG8_LDB(B0, 1, 0); PG8_SCHED; PG8_LDA(At, 1, 0); PG8_STAGE(PG8_SA(0, 1), a2 + hstep, voffA);
            PG8_WAIT_L(8); PG8_BAR; PG8_WAIT_L(0); PG8_MMA(0, 0, At, B0); PG8_BAR; PG8_SCHED;
            PG8_LDB(B1, 1, 1); PG8_STAGE(PG8_SB(1, 0), b3, voffB);
            PG8_BAR; PG8_WAIT_L(0); PG8_MMA(0, 1, At, B1); PG8_BAR;
            PG8_LDA(At, 1, 1); PG8_STAGE(PG8_SA(1, 0), a3, voffA);
            PG8_BAR; PG8_WAIT_L(0); PG8_MMA(1, 0, At, B0); PG8_BAR; PG8_SCHED;
            PG8_STAGE(PG8_SB(1, 1), b3 + hstep, voffB);
            PG8_WAIT_V(6); PG8_BAR; PG8_MMA(1, 1, At, B1); PG8_BAR;
            }
        }
        if constexpr (ALIGN_EPI) { if (wr == 0) PG8_BAR; }
        if constexpr (!Epi::AFTER_DRAIN) { E(acc, cur, wr, wc, fr, fq); S.done(cur); }
        if (!has_next) break;
#pragma unroll
        for (int a = 0; a < 2; ++a)
#pragma unroll
            for (int b = 0; b < 2; ++b)
#pragma unroll
                for (int m = 0; m < 4; ++m)
#pragma unroll
                    for (int n = 0; n < 2; ++n) acc[a][b][m][n] = (f32x4){0.f, 0.f, 0.f, 0.f};
        cur = nxt; cA = nA; cB = nB; ++ui;
        if constexpr (ALIGN_EPI) { if (wr == 1) PG8_BAR; }
    }
    PG8_WAIT_V(0);
    if constexpr (!ALIGN_EPI) { if (wr == 0) PG8_BAR; }
    PG8_BAR;
    if constexpr (Epi::AFTER_DRAIN) { E.fused(acc, cur, wr, wc, fr, fq, lds, wid, lane); S.done(cur); }
#undef PG8_SA
#undef PG8_SB
#undef PG8_STAGE
#undef PG8_LDA
#undef PG8_LDB
#undef PG8_MMA
#undef PG8_WAIT_V
#undef PG8_WAIT_L
#undef PG8_BAR
#undef PG8_SCHED
}
}

#define XB_TMO      128
#define XB_XCNT(j)  (256  + 64 * (j))
#define XB_XSUB(j)  (1280 + 64 * (j))
#define XB_XGEN(j)  (2304 + 64 * (j))
#define XB_TOP      3328
#define XB_TOPGEN   3392
#define XCD_BAR_WORDS 3456
#define XB_SPIN_CAP (1u << 18)

__device__ __forceinline__ unsigned xb_ld(unsigned* p)              { return __hip_atomic_load(p, __ATOMIC_RELAXED, __HIP_MEMORY_SCOPE_AGENT); }
__device__ __forceinline__ unsigned xb_add(unsigned* p, unsigned v) { return __hip_atomic_fetch_add(p, v, __ATOMIC_RELAXED, __HIP_MEMORY_SCOPE_AGENT); }
__device__ __forceinline__ unsigned xb_xcc_id() { return (unsigned)__builtin_amdgcn_s_getreg((3 << 11) | 20) & 0xFu; }
#define XB_SPIN(cond, bar) do { unsigned _sp = 0; while (cond) { __builtin_amdgcn_s_sleep(1); \
    if ((++_sp & 255u) == 0u) { if (xb_ld(&(bar)[XB_TMO])) break; if (_sp > XB_SPIN_CAP) { atomicAdd(&(bar)[XB_TMO], 1u); break; } } } } while (0)

struct XcdBarrier {
    unsigned* bar; unsigned x;
    volatile LAS unsigned* st;
};

__device__ __forceinline__ XcdBarrier xcd_barrier_post(unsigned* bar, volatile LAS unsigned* st) {
    XcdBarrier b; b.bar = bar; b.x = xb_xcc_id(); b.st = st;
    if (threadIdx.x == 0) (void)xb_add(&bar[XB_XCNT(b.x)], 1u);
    return b;
}
__device__ __forceinline__ void xcd_barrier_complete(unsigned* bar, unsigned x, unsigned& nloc, unsigned& nx) {
    const unsigned G = gridDim.x * gridDim.y * gridDim.z;
    unsigned sum, cnt, mine, sp = 0u;
    for (;;) {
        sum = 0u; cnt = 0u; mine = 0u;
#pragma unroll
        for (unsigned j = 0; j < 16; ++j) { const unsigned c = xb_ld(&bar[XB_XCNT(j)]); sum += c; cnt += (c > 0u) ? 1u : 0u; mine = (j == x) ? c : mine; }
        if (sum == G) break;
        __builtin_amdgcn_s_sleep(1);
        if ((++sp & 255u) == 0u) { if (xb_ld(&bar[XB_TMO])) break; if (sp > XB_SPIN_CAP) { atomicAdd(&bar[XB_TMO], 1u); break; } }
    }
    nloc = mine > 0u ? mine : 1u; nx = cnt > 0u ? cnt : 1u;
}

__device__ __forceinline__ void xcd_barrier(const XcdBarrier& b, int wv) {
    asm volatile("s_waitcnt vmcnt(0)" ::: "memory");
    __syncthreads();
    if (wv == 0 && __builtin_amdgcn_mbcnt_hi(~0u, __builtin_amdgcn_mbcnt_lo(~0u, 0u)) == 0) {
        unsigned* bar = b.bar;
        __builtin_amdgcn_s_waitcnt(0);
        unsigned nloc = b.st[0], nx = b.st[1];
        if (nloc == 0u) { xcd_barrier_complete(bar, b.x, nloc, nx); b.st[0] = nloc; b.st[1] = nx; }
        const unsigned old = xb_add(&bar[XB_XSUB(b.x)], 1u);
        const unsigned gen = old / nloc;
        if (old + 1u == (gen + 1u) * nloc) {
            __builtin_amdgcn_fence(__ATOMIC_RELEASE, "agent");
            asm volatile("s_waitcnt vmcnt(0)" ::: "memory");
            const unsigned og = xb_add(&bar[XB_TOP], 1u);
            const unsigned tg = og / nx;
            if (og + 1u == (tg + 1u) * nx) xb_add(&bar[XB_TOPGEN], 1u);
            else XB_SPIN(xb_ld(&bar[XB_TOPGEN]) == tg, bar);
            __builtin_amdgcn_fence(__ATOMIC_ACQUIRE, "agent");
            xb_add(&bar[XB_XGEN(b.x)], 1u);
            asm volatile("s_waitcnt vmcnt(0)" ::: "memory");
        } else {
            XB_SPIN(xb_ld(&bar[XB_XGEN(b.x)]) == gen, bar);
            __builtin_amdgcn_fence(__ATOMIC_ACQUIRE, "agent");
            asm volatile("s_waitcnt vmcnt(0)" ::: "memory");
        }
    }
    __syncthreads();
}

#define PHASE_IDS() int lane_ = __builtin_amdgcn_mbcnt_hi(~0u, __builtin_amdgcn_mbcnt_lo(~0u, 0u)); asm volatile("" : "+v"(lane_)); const int lane = lane_, wave = wv, tid = wv * 64 + lane_; (void)lane; (void)wave; (void)tid; size_t zoff_ = 0; asm volatile("" : "+s"(zoff_)); unsigned char* ws = p.ws + zoff_
typedef short v4i16_t __attribute__((ext_vector_type(4)));
__device__ __forceinline__ h16x4 tr_read4(const LAS unsigned char* p) { return __builtin_bit_cast(h16x4, __builtin_amdgcn_ds_read_tr16_b64_v4i16((LAS v4i16_t*)p)); }
__device__ __forceinline__ h16x8 vt_frag(const LAS unsigned char* vimg, int half_bytes, int et, int st, int lane) {
    const int hi = lane >> 5, blk = (lane >> 4) & 1, q = (lane & 15) >> 2, pp = lane & 3;
    const LAS unsigned char* a = vimg + et * half_bytes + (16 * st + 4 * hi + q) * 64 + (16 * blk + 4 * pp) * 2;
    const h16x4 lo = tr_read4(a), hh = tr_read4(a + 8 * 64);
    return (h16x8){lo[0], lo[1], lo[2], lo[3], hh[0], hh[1], hh[2], hh[3]};
}
__device__ __forceinline__ float silu_f(float z) { return z / (1.f + __expf(-z)); }

constexpr int SBL_K = 0, SBL_KB = 4608, SBL_V = 9216, SBL_VB = 4096, SBL_FLAG = 17408;
__device__ __forceinline__ void sb_unit(const Params& p, int unit, LAS unsigned char* lds, int wv) {
    PHASE_IDS();
    const h16* H = (const h16*)(ws + WS_H); h16* MIX = (h16*)(ws + WS_MIX);
    const int qb = unit & 15, bh = unit >> 4, hh = bh & 3, b = bh >> 2;
    const int r32 = lane & 31, hi = lane >> 5;
    const int t0 = 256 * qb, tb = t0 + 32 * wave, Ttop = 8 * qb + 7, Tdiag = 8 * qb + wave;
    LAS int* flags = (LAS int*)(lds + SBL_FLAG);
    const size_t qrow = (size_t)(b * SEQ + tb + r32) * 64;
    h16x8 qf[4];
#pragma unroll
    for (int ks = 0; ks < 4; ++ks) { qf[ks] = *(const h16x8*)(HCOL(H, C_SQ + hh * 64) + qrow + 16 * ks + 8 * hi); qf[ks] = qf[ks] * (h16)0.125f; }
    f32x16 o0 = {}, o1 = {};
    float R = 1.f; bool done = false;
    const int li = tid & 255, lrow = li >> 3, lc = li & 7; const bool isV = tid >= 256;
    const h16* gsrc = HCOL(H, (isV ? C_SV : C_SK) + hh * 64) + (size_t)(b * SEQ + lrow) * 64 + 8 * lc;
    const int ldst = isV ? SBL_V + (lc >> 2) * 2048 + lrow * 64 + (lc & 3) * 16 : SBL_K + lrow * 144 + lc * 16;
    const int lbuf = isV ? SBL_VB : SBL_KB;
    { const u32x4 v = *(const u32x4*)(gsrc + (size_t)Ttop * 32 * 64); *(LAS u32x4*)(lds + ldst) = v; }
    __syncthreads();
    int buf = 0, it = 0;
    for (int T = Ttop; T >= 0; --T, ++it) {
        u32x4 nxt = {0u, 0u, 0u, 0u};
        if (T > 0) nxt = *(const u32x4*)(gsrc + (size_t)(T - 1) * 32 * 64);
        if (T <= Tdiag && !done) {
            const LAS unsigned char* kimg = lds + SBL_K + buf * SBL_KB; const LAS unsigned char* vimg = lds + SBL_V + buf * SBL_VB;
            f32x16 z = {};
#pragma unroll
            for (int ks = 0; ks < 4; ++ks) { const h16x8 kf = *(const LAS h16x8*)(kimg + r32 * 144 + (16 * ks + 8 * hi) * 2); z = mfma32(kf, qf[ks], z); }
            float om[16], be[16];
            const bool diag = (T == Tdiag);
#pragma unroll
            for (int r = 0; r < 16; ++r) {
                const float u = __expf(fminf(z[r], 80.f)), rr = __builtin_amdgcn_rcpf(1.f + u);
                const bool valid = !diag || (crow(r, hi) < r32);
                om[r] = valid ? rr : 1.f; be[r] = valid ? u * rr : 0.f;
            }
            float G[4], Gp[4];
#pragma unroll
            for (int g = 0; g < 4; ++g) { G[g] = (om[4 * g] * om[4 * g + 1]) * (om[4 * g + 2] * om[4 * g + 3]); Gp[g] = xhalf(G[g], hi); }
            float E[4]; float run = R;
#pragma unroll
            for (int g = 3; g >= 0; --g) { E[g] = hi ? run : run * Gp[g]; run = run * (G[g] * Gp[g]); }
            h16x8 pf[2];
#pragma unroll
            for (int g = 0; g < 4; ++g) {
                const float w3 = E[g], w2 = w3 * om[4 * g + 3], w1 = w2 * om[4 * g + 2], w0 = w1 * om[4 * g + 1];
                pf[g >> 1][4 * (g & 1) + 0] = (h16)(be[4 * g + 0] * w0); pf[g >> 1][4 * (g & 1) + 1] = (h16)(be[4 * g + 1] * w1);
                pf[g >> 1][4 * (g & 1) + 2] = (h16)(be[4 * g + 2] * w2); pf[g >> 1][4 * (g & 1) + 3] = (h16)(be[4 * g + 3] * w3);
            }
            R = run;
#pragma unroll
            for (int st = 0; st < 2; ++st) {
                o0 = mfma32(vt_frag(vimg, 2048, 0, st, lane), pf[st], o0);
                o1 = mfma32(vt_frag(vimg, 2048, 1, st, lane), pf[st], o1);
            }
            done = (__builtin_amdgcn_ballot_w64(R >= 1e-37f) == 0ull);
        }
        if (T > 0) *(LAS u32x4*)(lds + ldst + (buf ^ 1) * lbuf) = nxt;
        if (lane == 0) flags[(it & 1) * 8 + wave] = done ? 1 : 0;
        __syncthreads();
        int alld = 1;
#pragma unroll
        for (int w = 0; w < 8; ++w) alld &= flags[(it & 1) * 8 + w];
        if (alld) break;
        buf ^= 1;
    }
#pragma unroll
    for (int et = 0; et < 2; ++et)
#pragma unroll
        for (int g = 0; g < 4; ++g) {
            const int e = 32 * et + 8 * g + 4 * hi;
            const h16x4 zz = *(const h16x4*)(HCOL(H, C_SZ + hh * 64) + qrow + e);
            h16x4 ov;
#pragma unroll
            for (int i = 0; i < 4; ++i) { const float ov_f = (et ? o1[4 * g + i] : o0[4 * g + i]); ov[i] = (h16)(ov_f * silu_f((float)zz[i])); }
            *(h16x4*)(MIX + (size_t)(b * SEQ + tb + r32) * DM + 384 + hh * 64 + e) = ov;
        }
    __syncthreads();
}

constexpr int NSL_K = 0, NSL_KB = 9216, NSL_V = 18432, NSL_VB = 8192, NSL_BT = 34816, NSL_IMP = 36864, NSL_ACCW = 6400, NSL_Q = NSL_IMP + 8 * NSL_ACCW, NSL_END = NSL_Q + 8 * 6 * 1024;
constexpr int PRETOUCH = 0, DUMMY_SELCOLD = 0, REP_SEL = 1, REP_WIN = 1, REP_CMP = 1, REP_TOPK = 1, REP_SETUP = 1, REP_EPI = 1, XTRA_BAR = 0;
constexpr float NSA_NEG = -1e30f, NSA_MINIT = -1e20f, NSA_THR = 10.f;
struct NsaW { const LAS h16x8* qf; f32x4 o[3][4]; f32x4 cvv, mv, lv; f32x4 la[3]; };
#define WCV(hh) W.cvv[hh]
#define WM(hh) W.mv[hh]
#define WL(hh) W.lv[hh]
typedef short s16x8 __attribute__((ext_vector_type(8)));
__device__ __forceinline__ f32x4 mfma16b(h16x8 vfrag, u32x4 p, f32x4 c) { return __builtin_amdgcn_mfma_f32_16x16x32_bf16(__builtin_bit_cast(s16x8, vfrag), __builtin_bit_cast(s16x8, p), c, 0, 0, 0); }
__device__ __forceinline__ float vmax3(float a, float b, float c) { float r; asm("v_max3_f32 %0, %1, %2, %3" : "=v"(r) : "v"(a), "v"(b), "v"(c)); return r; }
__device__ __forceinline__ float max4(float v, int hi) { v = fmaxf(v, __shfl_xor(v, 16)); return fmaxf(v, xhalf(v, hi)); }
__device__ __forceinline__ float sum4(float v, int hi) { v += __shfl_xor(v, 16); return v + xhalf(v, hi); }

template <int MODE>
__device__ __forceinline__ void nsa_pass(NsaW& W, const h16* kbase, const h16* vbase, int pitch, int kt_lo, int kt_hi, int tw, int t, unsigned long long sel,
                                         LAS unsigned char* lds, const LAS float* BT, LAS float* impw, int tid, int lane, int wave) {
    const int fr = lane & 15, kq = lane >> 4, hi = lane >> 5;
    const int lc = tid & 7, lr0 = tid >> 3, maxrow = 32 * kt_hi + 31;
    const int kdst0 = NSL_K + lr0 * 144 + lc * 16;
    const int vdst0 = NSL_V + (lr0 >> 5) * 4096 + (lc >> 2) * 2048 + (lr0 & 31) * 64 + (lc & 3) * 16;
    const int stg_lo = kt_lo >> 1, stg_hi = kt_hi >> 1;
#define NSA_STAGE_LOAD(stg, k0, v0) do { int r0_ = 64 * (stg) + lr0; r0_ = r0_ > maxrow ? maxrow : r0_; \
        k0 = *(const u32x4*)(kbase + (size_t)r0_ * pitch + 8 * lc); v0 = *(const u32x4*)(vbase + (size_t)r0_ * pitch + 8 * lc); } while (0)
#define NSA_STAGE_STORE(b, k0, v0) do { *(LAS u32x4*)(lds + kdst0 + (b) * NSL_KB) = k0; *(LAS u32x4*)(lds + vdst0 + (b) * NSL_VB) = v0; } while (0)
    { u32x4 k0, v0; NSA_STAGE_LOAD(stg_lo, k0, v0); NSA_STAGE_STORE(0, k0, v0); }
    __syncthreads();
    int buf = 0; float prev_carry = 0.f; bool first = true;
    for (int stg = stg_lo; stg <= stg_hi; ++stg) {
        u32x4 nk0 = {0u, 0u, 0u, 0u}, nv0 = nk0;
        if (stg < stg_hi) NSA_STAGE_LOAD(stg + 1, nk0, nv0);
      for (int h2 = 0; h2 < 2; ++h2) {
        const int kt = 2 * stg + h2;
        bool act = (kt >= kt_lo) && (kt <= kt_hi);
        if (MODE <= 1) act = act && (512 * kt + 16 <= tw);
        else if (MODE == 2) act = act && (32 * kt <= tw + 15) && (__builtin_amdgcn_ballot_w64((sel >> stg) & 1ull) != 0ull);
        else act = act && !(32 * kt + 31 < tw - 511 || 32 * kt > tw + 15);
        if (act) {
            const LAS unsigned char* kimg = lds + NSL_K + buf * NSL_KB + h2 * (32 * 144); const LAS unsigned char* vimg = lds + NSL_V + buf * NSL_VB + h2 * 4096;
            h16x8 kf[2][2];
#pragma unroll
            for (int sub = 0; sub < 2; ++sub)
#pragma unroll
                for (int ks = 0; ks < 2; ++ks) kf[sub][ks] = *(const LAS h16x8*)(kimg + (16 * sub + fr) * 144 + (32 * ks + 8 * kq) * 2);
            h16x8 vf[4];
            if (MODE != 0) {
#pragma unroll
                for (int et = 0; et < 4; ++et) {
                    const LAS unsigned char* a = vimg + (et >> 1) * 2048 + (4 * kq + ((lane & 15) >> 2)) * 64 + (16 * (et & 1) + 4 * (lane & 3)) * 2;
                    const h16x4 lo = tr_read4(a), hh4 = tr_read4(a + 16 * 64);
                    vf[et] = (h16x8){lo[0], lo[1], lo[2], lo[3], hh4[0], hh4[1], hh4[2], hh4[3]};
                }
            }
            const bool selbit = (MODE == 2) ? (((sel >> stg) & 1ull) != 0ull) : true;
            const int relmin = (MODE <= 1) ? tw - (16 * (32 * kt + 31) + 31) : tw - (32 * kt + 31);
            const bool farflag = (relmin >= 113) && (MODE != 3 || (tw + 15 - 32 * kt) < 512);
            float Lloc[2] = {0.f, 0.f}, Llast[2] = {0.f, 0.f};
            const unsigned mk = selbit ? 0xffffffffu : 0u;
            f32x4 sn[2];
            { const h16x8 q0 = W.qf[0 * 64 + lane], q1 = W.qf[1 * 64 + lane];
#pragma unroll
              for (int sub = 0; sub < 2; ++sub) { sn[sub] = mfma16(kf[sub][0], q0, (f32x4){0.f, 0.f, 0.f, 0.f}); sn[sub] = mfma16(kf[sub][1], q1, sn[sub]); } }
#pragma unroll
            for (int hh = 0; hh < 3; ++hh) {
                f32x4 s[2]; s[0] = sn[0]; s[1] = sn[1];
                if (hh < 2) { const h16x8 q0 = W.qf[((hh + 1) * 2 + 0) * 64 + lane], q1 = W.qf[((hh + 1) * 2 + 1) * 64 + lane];
#pragma unroll
                  for (int sub = 0; sub < 2; ++sub) { sn[sub] = mfma16(kf[sub][0], q0, (f32x4){0.f, 0.f, 0.f, 0.f}); sn[sub] = mfma16(kf[sub][1], q1, sn[sub]); } }
                if (!farflag) {
                    const float nb = -BT[hh * 128 + 127];
                    float bb[2][4];
#pragma unroll
                    for (int sub = 0; sub < 2; ++sub)
#pragma unroll
                        for (int r = 0; r < 4; ++r) {
                            const int key = 32 * kt + 16 * sub + 4 * kq + r;
                            const int rel = (MODE <= 1) ? t - (16 * key + 31) : t - key;
                            const int ri = rel < 0 ? 0 : (rel > 127 ? 127 : rel);
                            bb[sub][r] = ((const volatile LAS float*)BT)[hh * 128 + ri];
                        }
#pragma unroll
                    for (int sub = 0; sub < 2; ++sub)
#pragma unroll
                        for (int r = 0; r < 4; ++r) {
                            const int key = 32 * kt + 16 * sub + 4 * kq + r;
                            const int rel = (MODE <= 1) ? t - (16 * key + 31) : t - key;
                            bool v = rel >= 0;
                            if (MODE == 3) v = v && rel < 512;
                            s[sub][r] = v ? s[sub][r] + (bb[sub][r] + nb) : NSA_NEG;
                        }
                }
#pragma unroll
                for (int sub = 0; sub < 2; ++sub)
#pragma unroll
                    for (int r = 0; r < 4; ++r) s[sub][r] = __builtin_amdgcn_exp2f(s[sub][r]);
                if (MODE == 0) {
                    WL(hh) += ((s[0][0] + s[0][1]) + (s[0][2] + s[0][3])) + ((s[1][0] + s[1][1]) + (s[1][2] + s[1][3]));
                } else {
                    if (MODE == 1) {
#pragma unroll
                        for (int sub = 0; sub < 2; ++sub) { s[sub] = s[sub] * WL(hh); Lloc[sub] += (s[sub][0] + s[sub][1]) + (s[sub][2] + s[sub][3]); Llast[sub] += s[sub][3]; }
                    }
                    u32x4 pu; pu.x = pk2b(s[0][0], s[0][1]); pu.y = pk2b(s[0][2], s[0][3]); pu.z = pk2b(s[1][0], s[1][1]); pu.w = pk2b(s[1][2], s[1][3]);
                    if (MODE == 2) { pu.x &= mk; pu.y &= mk; pu.z &= mk; pu.w &= mk; }
                    if (MODE >= 2) { const u32x4 ones = {0x3f803f80u, 0x3f803f80u, 0x3f803f80u, 0x3f803f80u}; W.la[hh] = __builtin_amdgcn_mfma_f32_16x16x32_bf16(__builtin_bit_cast(s16x8, ones), __builtin_bit_cast(s16x8, pu), W.la[hh], 0, 0, 0); }
#pragma unroll
                    for (int et = 0; et < 4; ++et) W.o[hh][et] = mfma16b(vf[et], pu, W.o[hh][et]);
                }
            }
            first = false;
            if (MODE == 1) {
                const float up0 = __shfl(Llast[0], (lane - 16) & 63), up1 = __shfl(Llast[1], (lane - 16) & 63);
                const float own0 = Lloc[0] + (kq ? up0 : prev_carry), own1 = Lloc[1] + (kq ? up1 : up0);
                prev_carry = up1;
                impw[fr * 65 + 8 * kt + kq] = own0; impw[fr * 65 + 8 * kt + 4 + kq] = own1;
            }
        }
      }
        if (stg < stg_hi) NSA_STAGE_STORE(buf ^ 1, nk0, nv0);
        __syncthreads();
        if (MODE == 2) for (int xb = 0; xb < XTRA_BAR; ++xb) __syncthreads();
        buf ^= 1;
    }
#undef NSA_STAGE_LOAD
#undef NSA_STAGE_STORE
}

__device__ __forceinline__ void nsa_unit(const Params& p, int unit, LAS unsigned char* lds, int wv, int skip = 0) {
    PHASE_IDS();
    const h16* H = (const h16*)(ws + WS_H); h16* MIX = (h16*)(ws + WS_MIX);
    const int ub = 31 - (unit >> 4), bg = unit & 15, g = bg & 1, b = bg >> 1;
    const int fr = lane & 15, kq = lane >> 4, hi = lane >> 5;
    const int t0 = 128 * ub, tw = t0 + 16 * wave, t = tw + fr, cur = tw >> 6;
    LAS float* BT = (LAS float*)(lds + NSL_BT); LAS float* impw = (LAS float*)(lds + NSL_IMP + wave * NSL_ACCW); LAS h16* accw = (LAS h16*)(lds + NSL_IMP + wave * NSL_ACCW);
    NsaW W; W.qf = (const LAS h16x8*)(lds + NSL_Q) + wave * (6 * 64);
    const size_t hrow = (size_t)(b * SEQ + t) * 64;
    for (int rep = 0; rep < REP_SETUP; ++rep) {
    if (tid < 384) { const int hh = tid >> 7, d = tid & 127; int bk = d;
        if (d >= 16) bk = 16 + (d >= 19) + (d >= 21) + (d >= 24) + (d >= 27) + (d >= 31) + (d >= 35) + (d >= 40) + (d >= 46) + (d >= 52) + (d >= 59) + (d >= 67) + (d >= 77) + (d >= 87) + (d >= 99) + (d >= 113);
        BT[tid] = p.in[12][bk * 6 + g * 3 + hh] * 1.4426950408889634f; }
    for (int i = lane; i < 16 * 65; i += 64) impw[i] = 0.f;
    { LAS h16x8* qw = (LAS h16x8*)(lds + NSL_Q) + wave * (6 * 64);
#pragma unroll
    for (int hh = 0; hh < 3; ++hh)
#pragma unroll
        for (int ks = 0; ks < 2; ++ks) { h16x8 q = *(const h16x8*)(HCOL(H, C_NQ + (g * 3 + hh) * 64) + hrow + 32 * ks + 8 * kq); qw[(hh * 2 + ks) * 64 + lane] = q * (h16)(0.125f * 1.4426950408889634f); } }
    __syncthreads(); }
#define NSA_GATE(hh, i) (1.f / (1.f + __expf(-(float)HCOL(H, C_G)[hrow + (g * 3 + (hh)) * 3 + (i)])))
#define NSA_ACC(hh, et, scale, FIRST) do { LAS h16* dst_ = accw + fr * 200 + (hh) * 64 + 16 * (et) + 4 * kq; \
        f32x4 a_ = W.o[hh][et] * (scale); \
        if (!(FIRST)) { const h16x4 d_ = *(const LAS h16x4*)dst_; a_ = a_ + (f32x4){(float)d_[0], (float)d_[1], (float)d_[2], (float)d_[3]}; } \
        *(LAS h16x4*)dst_ = (h16x4){(h16)a_[0], (h16)a_[1], (h16)a_[2], (h16)a_[3]}; } while (0)
    if (PRETOUCH) {
        const size_t brow0 = (size_t)b * SEQ * 64; const int arr = tid >> 7, pg = tid & 127;
        const int colb = arr == 0 ? C_KS : (arr == 1 ? C_VS : (arr == 2 ? C_KW : C_VW));
        if (32 * pg <= t0 + 127) { const h16 v = ((const volatile h16*)(HCOL(H, colb + g * 64) + brow0))[(size_t)32 * pg * 64]; if (v == (h16)12345.f) impw[0] = 1.f; }
    }
    __syncthreads();
    const h16* KC = (const h16*)(ws + WS_KC) + (size_t)bg * 256 * 64; const h16* VC = (const h16*)(ws + WS_VCT) + (size_t)bg * 256 * 64;
    const int ct_hi = (t0 + 127 - 16) / 512;
#pragma unroll
    for (int hh = 0; hh < 3; ++hh) WL(hh) = 0.f;
    nsa_pass<0>(W, KC, VC, 64, 0, ct_hi, tw, t, 0ull, lds, BT, impw, tid, lane, wave);
#pragma unroll
    for (int hh = 0; hh < 3; ++hh) { const float lr = sum4(WL(hh), hi); WL(hh) = lr > 0.f ? 1.f / lr : 0.f;
#pragma unroll
        for (int et = 0; et < 4; ++et) W.o[hh][et] = (f32x4){0.f, 0.f, 0.f, 0.f}; }
    nsa_pass<1>(W, KC, VC, 64, 0, ct_hi, tw, t, 0ull, lds, BT, impw, tid, lane, wave);
    asm volatile("s_waitcnt lgkmcnt(0)" ::: "memory");
    unsigned long long sel;
    if (cur <= 15) sel = (2ull << cur) - 1ull;
    else {
        float v[16];
#pragma unroll
        for (int i = 0; i < 16; ++i) { const int j = 4 * i + kq; v[i] = (j >= 1 && j <= cur - 2) ? impw[fr * 65 + j] : -1.f; }
        sel = 1ull | (3ull << (cur - 1));
        for (int round = 0; round < 13; ++round) {
            float bv = v[0]; int bj = kq;
#pragma unroll
            for (int i = 1; i < 16; ++i) if (v[i] > bv) { bv = v[i]; bj = 4 * i + kq; }
            { const float ov = __shfl_xor(bv, 16); const int oj = __shfl_xor(bj, 16); if (ov > bv || (ov == bv && oj < bj)) { bv = ov; bj = oj; } }
            { const float ov = __shfl_xor(bv, 32); const int oj = __shfl_xor(bj, 32); if (ov > bv || (ov == bv && oj < bj)) { bv = ov; bj = oj; } }
            sel |= 1ull << bj;
#pragma unroll
            for (int i = 0; i < 16; ++i) v[i] = (4 * i + kq == bj) ? -1.f : v[i];
        }
    }
    asm volatile("s_waitcnt lgkmcnt(0)" ::: "memory");
#pragma unroll
    for (int hh = 0; hh < 3; ++hh) { const float sc = NSA_GATE(hh, 0);
#pragma unroll
        for (int et = 0; et < 4; ++et) NSA_ACC(hh, et, sc, true); }
    const size_t brow = (size_t)b * SEQ * 64;
    for (int rep = 0; rep < ((skip & 1) ? 0 : REP_SEL); ++rep) {
#pragma unroll
    for (int hh = 0; hh < 3; ++hh) { W.la[hh] = (f32x4){0.f, 0.f, 0.f, 0.f};
#pragma unroll
        for (int et = 0; et < 4; ++et) W.o[hh][et] = (f32x4){0.f, 0.f, 0.f, 0.f}; }
    if (DUMMY_SELCOLD && rep == 0) nsa_pass<2>(W, HCOL(H, C_SK + (g * 2) * 64) + brow, HCOL(H, C_SV + (g * 2) * 64) + brow, 64, 0, (t0 + 127) >> 5, tw, t, sel, lds, BT, impw, tid, lane, wave);
    else
    nsa_pass<2>(W, HCOL(H, C_KS + g * 64) + brow, HCOL(H, C_VS + g * 64) + brow, 64, 0, (t0 + 127) >> 5, tw, t, sel, lds, BT, impw, tid, lane, wave);
    }
#pragma unroll
    for (int hh = 0; hh < 3; ++hh) { const float lr = W.la[hh][0]; const float sc = lr > 0.f ? NSA_GATE(hh, 1) / lr : 0.f;
#pragma unroll
        for (int et = 0; et < 4; ++et) NSA_ACC(hh, et, sc, false); }
    for (int rep = 0; rep < ((skip & 2) ? 0 : REP_WIN); ++rep) {
#pragma unroll
    for (int hh = 0; hh < 3; ++hh) { W.la[hh] = (f32x4){0.f, 0.f, 0.f, 0.f};
#pragma unroll
        for (int et = 0; et < 4; ++et) W.o[hh][et] = (f32x4){0.f, 0.f, 0.f, 0.f}; }
    nsa_pass<3>(W, HCOL(H, C_KW + g * 64) + brow, HCOL(H, C_VW + g * 64) + brow, 64, (t0 - 511 < 0) ? 0 : (t0 - 511) >> 5, (t0 + 127) >> 5, tw, t, 0ull, lds, BT, impw, tid, lane, wave);
    }
#pragma unroll
    for (int hh = 0; hh < 3; ++hh) { const float lr = W.la[hh][0]; const float sc = lr > 0.f ? NSA_GATE(hh, 2) / lr : 0.f;
#pragma unroll
        for (int et = 0; et < 4; ++et) NSA_ACC(hh, et, sc, false); }
    asm volatile("s_waitcnt lgkmcnt(0)" ::: "memory");
    for (int rep = 0; rep < REP_EPI; ++rep)
#pragma unroll
    for (int it = 0; it < 6; ++it) {
        const int c = it * 64 + lane, row = c / 24, cc = c % 24;
        const h16x8 av = *(const LAS h16x8*)(accw + row * 200 + cc * 8);
        const size_t grow = (size_t)(b * SEQ + tw + row);
        const h16x8 zz = *(const h16x8*)(HCOL(H, C_NZ + g * 192 + cc * 8) + grow * 64);
        h16x8 ov;
#pragma unroll
        for (int j = 0; j < 8; ++j) ov[j] = (h16)((float)av[j] * silu_f((float)zz[j]));
        *(h16x8*)(MIX + grow * DM + g * 192 + cc * 8) = ov;
    }
    __syncthreads();
}

#define LDS_WAIT() asm volatile("s_waitcnt lgkmcnt(0)" ::: "memory")
__device__ __forceinline__ void tr_item(const float* W, int ldw, int srccol0, h16* WT, int K, int dstrow0, int k0, LAS float* scr, int lane) {
#pragma unroll 8
    for (int i = 0; i < 32; ++i) { const int kk = 2 * i + (lane >> 5); scr[kk * 33 + (lane & 31)] = srccol0 >= 0 ? W[(size_t)(k0 + kk) * ldw + srccol0 + (lane & 31)] : 0.f; }
    LDS_WAIT(); asm volatile("" ::: "memory");
    const int c = lane & 7;
#pragma unroll
    for (int j = 0; j < 4; ++j) { const int n = (lane >> 3) + 8 * j; const LAS float* s = scr + (8 * c) * 33 + n;
        u32x4 o; o.x = pk2h(s[0 * 33], s[1 * 33]); o.y = pk2h(s[2 * 33], s[3 * 33]); o.z = pk2h(s[4 * 33], s[5 * 33]); o.w = pk2h(s[6 * 33], s[7 * 33]);
        *(u32x4*)(WT + (size_t)(dstrow0 + n) * K + k0 + 8 * c) = o; }
    LDS_WAIT(); asm volatile("" ::: "memory");
}

__device__ __forceinline__ void prologue(const Params& p, LAS unsigned char* lds, int wv) {
    PHASE_IDS();
    LAS float* scr = (LAS float*)(lds + wave * 16384);
    const int gw = blockIdx.x * 8 + wave, NGW = gridDim.x * 8;
    constexpr int I_IN = 16 * (NH / 32), I_OUT = 16 * 32, I_C1 = 32 * 4, I_C2 = 2 * 2;
    constexpr int N_IN = 2 * I_IN, N_OUT = 2 * I_OUT, N_C1 = 4 * I_C1, N_C2 = 4 * I_C2, N_PB = 128;
    constexpr int NITEMS = N_IN + N_OUT + N_C1 + N_C2 + N_PB;
    for (int it = gw; it < NITEMS; it += NGW) {
        int r = it;
        if (r < N_IN) { const int l = r / I_IN, q = r % I_IN, kb = q / (NH / 32), nb = q % (NH / 32), n0 = 32 * nb;
            const int src = n0 < 1152 ? n0 : (n0 < 4096 ? n0 + 18 : (n0 == 4096 ? 1152 : -1));
            tr_item(p.in[1] + (size_t)l * 1024 * DIN, DIN, src, (h16*)(ws + WS_WINT) + (size_t)l * NH * 1024, 1024, n0, 64 * kb, scr, lane); continue; }
        r -= N_IN;
        if (r < N_OUT) { const int l = r / I_OUT, q = r % I_OUT, kb = q / 32, nb = q % 32;
            tr_item(p.in[9] + (size_t)l * 1024 * 1024, 1024, 32 * nb, (h16*)(ws + WS_WOUTT) + (size_t)l * 1024 * 1024, 1024, 32 * nb, 64 * kb, scr, lane); continue; }
        r -= N_OUT;
        if (r < N_C1) { const int lk = r / I_C1, l = lk >> 1, kv = lk & 1, q = r % I_C1, kb = q / 4, nb = q % 4;
            tr_item((kv ? p.in[5] : p.in[3]) + (size_t)l * 2048 * 128, 128, 32 * nb, (h16*)(ws + WS_WC1T) + (size_t)lk * 128 * 2048, 2048, 32 * nb, 64 * kb, scr, lane); continue; }
        r -= N_C1;
        if (r < N_C2) { const int lk = r / I_C2, l = lk >> 1, kv = lk & 1, q = r % I_C2, kb = q / 2, nb = q % 2;
            tr_item((kv ? p.in[6] : p.in[4]) + (size_t)l * 128 * 64, 64, 32 * nb, (h16*)(ws + WS_WC2T) + (size_t)lk * 64 * 128, 128, 32 * nb, 64 * kb, scr, lane); continue; }
        r -= N_C2;
        {
            const int lk = r >> 5, l = lk >> 1, kv = lk & 1, c = r & 31;
            const float* w1 = (kv ? p.in[5] : p.in[3]) + (size_t)l * 2048 * 128; const float* pos = p.in[2] + (size_t)l * 2048;
            float a0 = 0.f, a1 = 0.f;
#pragma unroll 8
            for (int ii = 0; ii < 64; ++ii) { const int i = c * 64 + ii; const float pv = pos[i]; a0 += pv * w1[(size_t)i * 128 + lane]; a1 += pv * w1[(size_t)i * 128 + 64 + lane]; }
            float* o = (float*)(ws + WS_PBP) + ((size_t)lk * 32 + c) * 128; o[lane] = a0; o[64 + lane] = a1;
        }
    }
    const float* x = p.in[0]; h16* xh = (h16*)(ws + WS_XH);
    const size_t nvec = (size_t)MTOK * DM / 8;
    for (size_t i = (size_t)blockIdx.x * 512 + tid; i < nvec; i += (size_t)gridDim.x * 512) {
        const f32x4 a = *(const f32x4*)(x + i * 8), b = *(const f32x4*)(x + i * 8 + 4);
        u32x4 o; o.x = pk2h(a[0], a[1]); o.y = pk2h(a[2], a[3]); o.z = pk2h(b[0], b[1]); o.w = pk2h(b[2], b[3]);
        *(u32x4*)(xh + i * 8) = o;
    }
}

__device__ __forceinline__ void ln_phase(const Params& p, int layer, int wv) {
    PHASE_IDS();
    const bool last = (layer == DEPTH - 1);
    const h16* Y = (const h16*)(ws + WS_H); const float* g = p.in[10] + (size_t)layer * DM; const float* bb = p.in[11] + (size_t)layer * DM; float* xout = p.out; h16* xh = (h16*)(ws + WS_XH);
    const int gw = blockIdx.x * 8 + wave, NGW = gridDim.x * 8;
    f32x4 gv[4], bv[4];
#pragma unroll
    for (int j = 0; j < 4; ++j) { gv[j] = *((const f32x4*)g + lane + 64 * j); bv[j] = *((const f32x4*)bb + lane + 64 * j); }
    constexpr int RB = 4;
    for (int m0 = gw * RB; m0 < MTOK; m0 += NGW * RB) {
        f32x4 v[RB][4]; float s[RB];
#pragma unroll
        for (int q = 0; q < RB; ++q) { const h16x4* yr = (const h16x4*)(Y + (size_t)(m0 + q) * DM) + lane; s[q] = 0.f;
#pragma unroll
            for (int j = 0; j < 4; ++j) { const h16x4 y4 = yr[64 * j]; v[q][j] = (f32x4){(float)y4[0], (float)y4[1], (float)y4[2], (float)y4[3]}; s[q] += (v[q][j][0] + v[q][j][1]) + (v[q][j][2] + v[q][j][3]); } }
#pragma unroll
        for (int o = 1; o < 64; o <<= 1) {
#pragma unroll
            for (int q = 0; q < RB; ++q) s[q] += __shfl_xor(s[q], o); }
        float s2[RB];
#pragma unroll
        for (int q = 0; q < RB; ++q) { const float mean = s[q] * (1.f / DM); s2[q] = 0.f;
#pragma unroll
            for (int j = 0; j < 4; ++j) { v[q][j] = v[q][j] - mean; s2[q] += (v[q][j][0] * v[q][j][0] + v[q][j][1] * v[q][j][1]) + (v[q][j][2] * v[q][j][2] + v[q][j][3] * v[q][j][3]); } }
#pragma unroll
        for (int o = 1; o < 64; o <<= 1) {
#pragma unroll
            for (int q = 0; q < RB; ++q) s2[q] += __shfl_xor(s2[q], o); }
#pragma unroll
        for (int q = 0; q < RB; ++q) { const float rstd = 1.f / sqrtf(s2[q] * (1.f / DM) + 1e-5f);
            f32x4* orow = (f32x4*)(xout + (size_t)(m0 + q) * DM) + lane; u32x2* hrow = (u32x2*)(xh + (size_t)(m0 + q) * DM) + lane;
#pragma unroll
            for (int j = 0; j < 4; ++j) { const f32x4 o = v[q][j] * rstd * gv[j] + bv[j];
                if (last) orow[64 * j] = o; else { u32x2 w; w.x = pk2h(o[0], o[1]); w.y = pk2h(o[2], o[3]); hrow[64 * j] = w; } } }
    }
}

__device__ __forceinline__ float gelu_tanh(float x) {
    const float y = 0.7978845608028654f * (x + 0.044715f * x * x * x);
    const float t = 1.f - 2.f / (1.f + __expf(2.f * y));
    return 0.5f * x * (1.f + t);
}
__device__ __forceinline__ void compress_unit(const Params& p, int layer, int cu, LAS unsigned char* lds, int wv) {
    PHASE_IDS();
    const int nt = cu & 7, kv = (cu >> 3) & 1, g = (cu >> 4) & 1, b = cu >> 5, lk = layer * 2 + kv;
    const h16* H = (const h16*)(ws + WS_H);
    const h16* W1T = (const h16*)(ws + WS_WC1T) + (size_t)lk * 128 * 2048;
    const h16* W2T = (const h16*)(ws + WS_WC2T) + (size_t)lk * 64 * 128;
    const float* PBP = (const float*)(ws + WS_PBP) + (size_t)lk * 32 * 128;
    LAS h16* hid = (LAS h16*)lds;
    const int fr = lane & 15, kq = lane >> 4;
    const int colbase = (kv ? C_VC : C_KC) + g * 64;
    const int j0 = 16 * wave;
    f32x4 acc[2] = {{0.f, 0.f, 0.f, 0.f}, {0.f, 0.f, 0.f, 0.f}};
    const h16* bptr = W1T + (size_t)(j0 + fr) * 2048 + 8 * kq;
    const int n_a0 = 32 * nt + fr, n_a1 = n_a0 + 16;
#pragma unroll 8
    for (int ks = 0; ks < 64; ++ks) {
        const int pp = ks >> 1, dd = 32 * (ks & 1) + 8 * kq;
        int tok0 = 16 * n_a0 + pp; tok0 = tok0 > SEQ - 1 ? SEQ - 1 : tok0;
        int tok1 = 16 * n_a1 + pp; tok1 = tok1 > SEQ - 1 ? SEQ - 1 : tok1;
        const h16x8 a0 = *(const h16x8*)(HCOL(H, colbase) + (size_t)(b * SEQ + tok0) * 64 + dd);
        const h16x8 a1 = *(const h16x8*)(HCOL(H, colbase) + (size_t)(b * SEQ + tok1) * 64 + dd);
        const h16x8 bf = *(const h16x8*)(bptr + 32 * ks);
        acc[0] = mfma16(a0, bf, acc[0]); acc[1] = mfma16(a1, bf, acc[1]);
    }
    float bias = 0.f;
#pragma unroll 8
    for (int c = 0; c < 32; ++c) bias += PBP[c * 128 + j0 + fr];
#pragma unroll
    for (int rt = 0; rt < 2; ++rt)
#pragma unroll
        for (int r = 0; r < 4; ++r) hid[(16 * rt + 4 * kq + r) * 136 + j0 + fr] = (h16)gelu_tanh(acc[rt][r] + bias);
    __syncthreads();
    {
        const int rt = wave >> 2, dt = wave & 3;
        f32x4 o = {0.f, 0.f, 0.f, 0.f};
#pragma unroll
        for (int ks = 0; ks < 4; ++ks) {
            const h16x8 a = *(const LAS h16x8*)(hid + (16 * rt + fr) * 136 + 32 * ks + 8 * kq);
            const h16x8 bf = *(const h16x8*)(W2T + (size_t)(16 * dt + fr) * 128 + 32 * ks + 8 * kq);
            o = mfma16(a, bf, o);
        }
        const int d = 16 * dt + fr, n0 = 32 * nt + 16 * rt + 4 * kq;
        if (kv == 0) { h16* KC = (h16*)(ws + WS_KC) + (size_t)(b * 2 + g) * 256 * 64;
#pragma unroll
            for (int r = 0; r < 4; ++r) KC[(size_t)(n0 + r) * 64 + d] = (h16)o[r]; }
        else { h16* VC = (h16*)(ws + WS_VCT) + (size_t)(b * 2 + g) * 256 * 64;
#pragma unroll
            for (int r = 0; r < 4; ++r) ((unsigned short*)VC)[(size_t)(n0 + r) * 64 + d] = (unsigned short)(pk2b(o[r], 0.f) & 0xffffu); }
    }
    __syncthreads();
}

constexpr int HGL_QS = 0, HGL_KS = 17408, HGL_BS = 34816, HGL_QT = 52224, HGL_VT = 61440, HGL_ST = 70656, HGL_AT = 79872, HGL_OS = 89088, HGL_TOT = 105728;
__device__ __forceinline__ float hg_lb(const Params& p, int layer, int idx) {
    if (layer == 0) return 0.f;
    const float a0 = p.in[7][idx], a1 = p.in[7][384 + idx];
    return 1.f / (1.f + __expf(a0 - a1));
}
constexpr int HG3_KT = 0, HG3_VT = 9216, HG3_UT = 18432, HG3_TOT = 35072, HG3_DL = 37120;
__device__ __forceinline__ void hg_state_unit(const Params& p, int layer, int unit, LAS unsigned char* lds, int wv) {
    PHASE_IDS();
    const h16* H = (const h16*)(ws + WS_H);
    float* HGU = (float*)(ws + WS_HGU); float* HGD = (float*)(ws + WS_HGD); float* HGA = (float*)(ws + WS_HGA); float* HGDG = (float*)(ws + WS_HGDG);
    constexpr int NG = NCHUNK / HG_G;
    const int gi = unit % NG, bh = unit / NG, hd = bh % 6, b = bh / 6, c0 = gi * HG_G;
    const int d = tid & 63, seg = tid >> 6, e_own = tid >> 3, d0 = (tid & 7) * 8;
    LAS h16* KT = (LAS h16*)(lds + HG3_KT); LAS h16* VT = (LAS h16*)(lds + HG3_VT); LAS float* UT = (LAS float*)(lds + HG3_UT); LAS float* tot = (LAS float*)(lds + HG3_TOT); LAS float* DL = (LAS float*)(lds + HG3_DL);
    const float lbv = hg_lb(p, layer, hd * 64 + d), lbf = fmaxf(lbv, 1e-30f), oml = 1.f - lbv;
    float S[8], DGa[8];
#pragma unroll
    for (int j = 0; j < 8; ++j) { S[j] = 0.f; DGa[j] = 1.f; }
    h16 fr_[8], vr_[8];
#define HG_LOAD_RAW2(c_) do { const size_t base_ = (size_t)(b * SEQ + 64 * (c_) + 8 * seg) * 64 + d; \
        _Pragma("unroll") for (int i = 0; i < 8; ++i) { fr_[i] = HCOL(H, C_HF + hd * 64)[base_ + (size_t)i * 64]; vr_[i] = HCOL(H, C_HI + hd * 64)[base_ + (size_t)i * 64]; } } while (0)
    HG_LOAD_RAW2(c0);
    for (int c = c0; c < c0 + HG_G; ++c) {
        const size_t uu = (size_t)bh * 64 + c;
        float bl[8], ky[8]; float cs = 0.f;
#pragma unroll
        for (int i = 0; i < 8; ++i) {
            const float f = (float)fr_[i]; const float e = __expf(-fabsf(f)), r = 1.f / (1.f + e);
            const float sig = f >= 0.f ? r : e * r, sigm = f >= 0.f ? e * r : r;
            cs += __logf(lbf + oml * sig); bl[i] = cs; ky[i] = oml * sigm;
        }
        tot[seg * 64 + d] = cs;
        { h16x8 vt;
#pragma unroll
          for (int i = 0; i < 8; ++i) vt[i] = vr_[i];
          *(LAS h16x8*)(VT + d * 72 + 8 * seg) = vt; }
        __syncthreads();
        float pre = 0.f, blast = 0.f;
#pragma unroll
        for (int s2 = 0; s2 < 8; ++s2) { const float v = tot[s2 * 64 + d]; blast += v; pre += s2 < seg ? v : 0.f; }
        { h16x8 kt;
#pragma unroll
          for (int i = 0; i < 8; ++i) kt[i] = (h16)(ky[i] * __expf(blast - (pre + bl[i])));
          *(LAS h16x8*)(KT + d * 72 + 8 * seg) = kt; }
        if (seg == 0) { const float dd = __expf(blast); DL[d] = dd; HGD[uu * 64 + d] = dd; }
        if (c + 1 < c0 + HG_G) HG_LOAD_RAW2(c + 1);
        __syncthreads();
        if (wave < 4) {
            const int et = wave >> 1, dt = wave & 1, r32 = lane & 31, hi = lane >> 5;
            f32x16 acc = {};
#pragma unroll
            for (int ks = 0; ks < 4; ++ks) {
                const h16x8 a = *(const LAS h16x8*)(VT + (32 * et + r32) * 72 + 16 * ks + 8 * hi);
                const h16x8 bf = *(const LAS h16x8*)(KT + (32 * dt + r32) * 72 + 16 * ks + 8 * hi);
                acc = mfma32(a, bf, acc);
            }
#pragma unroll
            for (int r = 0; r < 16; ++r) { const int e = 32 * et + crow(r, hi); HGU[(uu * 64 + e) * 64 + 32 * dt + r32] = acc[r]; UT[e * 65 + 32 * dt + r32] = acc[r]; }
        }
        __syncthreads();
#pragma unroll
        for (int j = 0; j < 8; ++j) { const float dd = DL[d0 + j]; S[j] = dd * S[j] + UT[e_own * 65 + d0 + j]; DGa[j] *= dd; }
    }
#undef HG_LOAD_RAW2
    {
        const size_t gu = (size_t)bh * NG + gi;
        *(f32x4*)(HGA + (gu * 64 + e_own) * 64 + d0) = (f32x4){S[0], S[1], S[2], S[3]}; *(f32x4*)(HGA + (gu * 64 + e_own) * 64 + d0 + 4) = (f32x4){S[4], S[5], S[6], S[7]};
        if (e_own == 0) { *(f32x4*)(HGDG + gu * 64 + d0) = (f32x4){DGa[0], DGa[1], DGa[2], DGa[3]}; *(f32x4*)(HGDG + gu * 64 + d0 + 4) = (f32x4){DGa[4], DGa[5], DGa[6], DGa[7]}; }
    }
    __syncthreads();
}
constexpr int HG2_QH = 0, HG2_KH = 9216, HG2_QD = 18432, HG2_KD = 35840, HG2_VT = 53248, HG2_ST = 62464, HG2_OS = 71680, HG2_TOT = 88320, HG2_G = 90368, HG2_E = 90880;
__device__ __forceinline__ void hg_out_unit(const Params& p, int layer, int unit, LAS unsigned char* lds, int wv) {
    PHASE_IDS();
    const h16* H = (const h16*)(ws + WS_H); h16* MIX = (h16*)(ws + WS_MIX);
    const float* HGU = (const float*)(ws + WS_HGU); const float* HGD = (const float*)(ws + WS_HGD);
    constexpr int NG = NCHUNK / HG_G;
    const int gi = unit % NG, bh = unit / NG, hd = bh % 6, b = bh / 6, c0 = gi * HG_G;
    const int d = tid & 63, seg = tid >> 6, e_own = tid >> 3, d0 = (tid & 7) * 8, I_own = seg >> 1;
    LAS h16* QH = (LAS h16*)(lds + HG2_QH); LAS h16* KH = (LAS h16*)(lds + HG2_KH); LAS float* QD = (LAS float*)(lds + HG2_QD); LAS float* KD = (LAS float*)(lds + HG2_KD);
    LAS h16* VT = (LAS h16*)(lds + HG2_VT); LAS h16* ST = (LAS h16*)(lds + HG2_ST); LAS float* OS = (LAS float*)(lds + HG2_OS); LAS float* tot = (LAS float*)(lds + HG2_TOT);
    LAS h16* GT = (LAS h16*)(lds + HG2_G); LAS h16* ET = (LAS h16*)(lds + HG2_E);
    const float lbv = hg_lb(p, layer, hd * 64 + d), lbf = fmaxf(lbv, 1e-30f), oml = 1.f - lbv;
    const float* nw = p.in[8] + (size_t)layer * 384 + hd * 64;
    float S[8];
#pragma unroll
    for (int j = 0; j < 8; ++j) S[j] = 0.f;
    { const float* HGA = (const float*)(ws + WS_HGA); const float* HGDG = (const float*)(ws + WS_HGDG);
      for (int gg = 0; gg < gi; ++gg) {
        const size_t gu = (size_t)bh * NG + gg;
        const f32x4 D0 = *(const f32x4*)(HGDG + gu * 64 + d0), D1 = *(const f32x4*)(HGDG + gu * 64 + d0 + 4);
        const f32x4 U0 = *(const f32x4*)(HGA + (gu * 64 + e_own) * 64 + d0), U1 = *(const f32x4*)(HGA + (gu * 64 + e_own) * 64 + d0 + 4);
#pragma unroll
        for (int j = 0; j < 4; ++j) { S[j] = D0[j] * S[j] + U0[j]; S[4 + j] = D1[j] * S[4 + j] + U1[j]; }
      } }
    h16 fr_[8], qr_[8], vr_[8];
#define HG_LOAD_RAW(c_) do { const size_t base_ = (size_t)(b * SEQ + 64 * (c_) + 8 * seg) * 64 + d; \
        _Pragma("unroll") for (int i = 0; i < 8; ++i) { fr_[i] = HCOL(H, C_HF + hd * 64)[base_ + (size_t)i * 64]; qr_[i] = HCOL(H, C_HQ + hd * 64)[base_ + (size_t)i * 64]; vr_[i] = HCOL(H, C_HI + hd * 64)[base_ + (size_t)i * 64]; } } while (0)
    HG_LOAD_RAW(c0);
    for (int c = c0; c < c0 + HG_G; ++c) {
        const int r0 = b * SEQ + 64 * c; const size_t uu = (size_t)bh * 64 + c;
        const f32x4 D0 = *(const f32x4*)(HGD + uu * 64 + d0), D1 = *(const f32x4*)(HGD + uu * 64 + d0 + 4);
        const f32x4 U0 = *(const f32x4*)(HGU + (uu * 64 + e_own) * 64 + d0), U1 = *(const f32x4*)(HGU + (uu * 64 + e_own) * 64 + d0 + 4);
        const h16x8 zg = *(const h16x8*)(HCOL(H, C_HZ + hd * 64) + (size_t)(r0 + (tid >> 3)) * 64 + (tid & 7) * 8);
        float bl[8], ky[8], qv[8]; float cs = 0.f;
#pragma unroll
        for (int i = 0; i < 8; ++i) {
            const float f = (float)fr_[i]; const float e = __expf(-fabsf(f)), r = 1.f / (1.f + e);
            const float sig = f >= 0.f ? r : e * r, sigm = f >= 0.f ? e * r : r;
            cs += __logf(lbf + oml * sig); bl[i] = cs; ky[i] = oml * sigm; qv[i] = (float)qr_[i];
        }
        tot[seg * 64 + d] = cs;
        { h16x8 vt;
#pragma unroll
          for (int i = 0; i < 8; ++i) vt[i] = vr_[i];
          *(LAS h16x8*)(VT + d * 72 + 8 * seg) = vt; }
        { h16x8 st;
#pragma unroll
          for (int j = 0; j < 8; ++j) st[j] = (h16)S[j];
          *(LAS h16x8*)(ST + e_own * 72 + d0) = st; }
        __syncthreads();
        float P[9]; P[0] = 0.f;
#pragma unroll
        for (int s2 = 0; s2 < 8; ++s2) P[s2 + 1] = P[s2] + tot[s2 * 64 + d];
        float pre = 0.f, beta = 0.f, betan = 0.f, mu = 0.f;
#pragma unroll
        for (int s2 = 0; s2 < 9; ++s2) { pre = (s2 == seg) ? P[s2] : pre; beta = (s2 == 2 * I_own) ? P[s2] : beta; betan = (s2 == 2 * I_own + 2) ? P[s2] : betan; mu = (s2 == 2 * I_own + 1) ? P[s2] : mu; }
#pragma unroll
        for (int i = 0; i < 8; ++i) {
            const int t = 8 * seg + i; const float bb = pre + bl[i];
            QH[t * 72 + d] = (h16)(qv[i] * __expf(bb - beta)); KH[t * 72 + d] = (h16)(ky[i] * __expf(betan - bb));
            QD[t * 68 + d] = qv[i] * __expf(bb - mu); KD[t * 68 + d] = ky[i] * __expf(mu - bb);
        }
        if (seg == 0) {
            GT[0 * 64 + d] = (h16)__expf(P[4] - P[2]); GT[1 * 64 + d] = (h16)__expf(P[6] - P[4]); GT[2 * 64 + d] = (h16)__expf(P[6] - P[2]);
            ET[0 * 64 + d] = (h16)1.f; ET[1 * 64 + d] = (h16)__expf(P[2]); ET[2 * 64 + d] = (h16)__expf(P[4]); ET[3 * 64 + d] = (h16)__expf(P[6]);
        }
        if (c + 1 < c0 + HG_G) HG_LOAD_RAW(c + 1);
        __syncthreads();
        {
            const int I = wave & 3, eh = wave >> 2, fr = lane & 15, kq = lane >> 4, trow = 16 * I + fr;
            h16x8 qh[2];
#pragma unroll
            for (int ks = 0; ks < 2; ++ks) qh[ks] = *(const LAS h16x8*)(QH + trow * 72 + 32 * ks + 8 * kq);
            f32x4 att[4];
#pragma unroll
            for (int J = 0; J < 4; ++J) att[J] = (f32x4){0.f, 0.f, 0.f, 0.f};
            {
                f32x4 ad = {0.f, 0.f, 0.f, 0.f};
#pragma unroll
                for (int q4 = 0; q4 < 4; ++q4) {
                    const f32x4 ka = *(const LAS f32x4*)(KD + trow * 68 + 16 * kq + 4 * q4), qa = *(const LAS f32x4*)(QD + trow * 68 + 16 * kq + 4 * q4);
#pragma unroll
                    for (int x = 0; x < 4; ++x) ad = __builtin_amdgcn_mfma_f32_16x16x4f32(ka[x], qa[x], ad, 0, 0, 0);
                }
#pragma unroll
                for (int r = 0; r < 4; ++r) ad[r] = (4 * kq + r <= fr) ? ad[r] : 0.f;
#pragma unroll
                for (int J = 0; J < 4; ++J) att[J] = (J == I) ? ad : att[J];
            }
#pragma unroll
            for (int J = 0; J < 3; ++J) {
                if (J < I) {
                    h16x8 kh0 = *(const LAS h16x8*)(KH + (16 * J + fr) * 72 + 8 * kq), kh1 = *(const LAS h16x8*)(KH + (16 * J + fr) * 72 + 32 + 8 * kq);
                    if (I - J >= 2) { const int gi2 = (I == 2) ? 0 : (J == 1 ? 1 : 2);
                        kh0 = kh0 * *(const LAS h16x8*)(GT + gi2 * 64 + 8 * kq); kh1 = kh1 * *(const LAS h16x8*)(GT + gi2 * 64 + 32 + 8 * kq); }
                    f32x4 a = {0.f, 0.f, 0.f, 0.f};
                    a = mfma16(kh0, qh[0], a); a = mfma16(kh1, qh[1], a);
                    att[J] = a;
                }
            }
            const h16x8 pf01 = {(h16)att[0][0], (h16)att[0][1], (h16)att[0][2], (h16)att[0][3], (h16)att[1][0], (h16)att[1][1], (h16)att[1][2], (h16)att[1][3]};
            const h16x8 pf23 = {(h16)att[2][0], (h16)att[2][1], (h16)att[2][2], (h16)att[2][3], (h16)att[3][0], (h16)att[3][1], (h16)att[3][2], (h16)att[3][3]};
            const h16x8 qe0 = qh[0] * *(const LAS h16x8*)(ET + I * 64 + 8 * kq), qe1 = qh[1] * *(const LAS h16x8*)(ET + I * 64 + 32 + 8 * kq);
#pragma unroll
            for (int e2 = 0; e2 < 2; ++e2) {
                const int et = 2 * eh + e2, erow = 16 * et + fr;
                f32x4 o = {0.f, 0.f, 0.f, 0.f};
                { const h16x4 v0 = *(const LAS h16x4*)(VT + erow * 72 + 4 * kq), v1 = *(const LAS h16x4*)(VT + erow * 72 + 16 + 4 * kq);
                  o = mfma16((h16x8){v0[0], v0[1], v0[2], v0[3], v1[0], v1[1], v1[2], v1[3]}, pf01, o); }
                if (I >= 2) { const h16x4 v0 = *(const LAS h16x4*)(VT + erow * 72 + 32 + 4 * kq), v1 = *(const LAS h16x4*)(VT + erow * 72 + 48 + 4 * kq);
                  o = mfma16((h16x8){v0[0], v0[1], v0[2], v0[3], v1[0], v1[1], v1[2], v1[3]}, pf23, o); }
                o = mfma16(*(const LAS h16x8*)(ST + erow * 72 + 8 * kq), qe0, o);
                o = mfma16(*(const LAS h16x8*)(ST + erow * 72 + 32 + 8 * kq), qe1, o);
#pragma unroll
                for (int r = 0; r < 4; ++r) OS[trow * 65 + 16 * et + 4 * kq + r] = o[r];
            }
        }
#pragma unroll
        for (int j = 0; j < 4; ++j) { S[j] = D0[j] * S[j] + U0[j]; S[4 + j] = D1[j] * S[4 + j] + U1[j]; }
        __syncthreads();
        {
            const int t = tid >> 3, e0 = (tid & 7) * 8;
            float o[8], ssq = 0.f;
#pragma unroll
            for (int j = 0; j < 8; ++j) { o[j] = OS[t * 65 + e0 + j]; ssq += o[j] * o[j]; }
            ssq += __shfl_xor(ssq, 1); ssq += __shfl_xor(ssq, 2); ssq += __shfl_xor(ssq, 4);
            const float rinv = 1.f / sqrtf(ssq * (1.f / 64.f) + 1e-6f);
            const f32x4 w0 = *(const f32x4*)(nw + e0), w1 = *(const f32x4*)(nw + e0 + 4);
            h16x8 ov;
#pragma unroll
            for (int j = 0; j < 8; ++j) { const float zz = (float)zg[j]; const float w = j < 4 ? w0[j & 3] : w1[j & 3];
                ov[j] = (h16)(o[j] * rinv * w * (zz / (1.f + __expf(-zz)))); }
            *(h16x8*)(MIX + (size_t)(r0 + t) * DM + 640 + hd * 64 + e0) = ov;
        }
    }
#undef HG_LOAD_RAW
    __syncthreads();
}

constexpr int DUMMY_NSA = 0, DUMMY_SKIP = 3, REP_P0 = 1, REP_P1 = 1, REP_P4 = 1, REP_P5 = 1, REP_P2 = 1, REP_NSA = 1, REP_SB = 1, REP_HG = 1;
constexpr int LDS_BYTES = 147456;
__global__ void __launch_bounds__(512, 2) mega(Params p) {
    extern __shared__ __attribute__((aligned(16))) unsigned char lds_raw[];
    LAS unsigned char* lds = (LAS unsigned char*)lds_raw;
    cg::grid_group grid = cg::this_grid();
    const int wv = __builtin_amdgcn_readfirstlane(threadIdx.x >> 6);
    { LAS unsigned* misc = (LAS unsigned*)(lds + LDS_BYTES - 64); if (threadIdx.x < 16) misc[threadIdx.x] = 0u; }
    __syncthreads();
    XcdBarrier xbar = xcd_barrier_post((unsigned*)(p.ws + WS_CTL), (volatile LAS unsigned*)(lds + LDS_BYTES - 64));
#define GRID_BAR() xcd_barrier(xbar, wv)

    for (int rep = 0; rep < REP_P0; ++rep) prologue(p, lds, wv);
    grid.sync();
    for (int layer = 0; layer < DEPTH; ++layer) {
        {
            size_t zoff_ = 0; asm volatile("" : "+s"(zoff_)); unsigned char* ws = p.ws + zoff_; h16* XH = (h16*)(ws + WS_XH); h16* Hb = (h16*)(ws + WS_H);
            pg8::Gemm g{(const pg8::bf16_t*)XH, (const pg8::bf16_t*)((h16*)(ws + WS_WINT) + (size_t)layer * NH * 1024), MTOK, NH, DM};
            pg8::StaticOrder S; S.init(MTOK, NH, gridDim.x, blockIdx.x);
            pg8::EpiH E{Hb, MTOK};
            for (int rep = 0; rep < REP_P1; ++rep) pg8::gemm_phase<pg8::EpiH, pg8::StaticOrder, true, true>(lds, g, S, E, wv);
        }
        GRID_BAR();
        for (int rep = 0; rep < REP_P2; ++rep)
        {
            constexpr int N_HG = 48 * (NCHUNK / HG_G), N_UNITS = N_HG + 256;
            unsigned* ctr = (unsigned*)(p.ws + WS_CTL + 32768) + 64 * (2 + layer);
            LAS int* qslot = (LAS int*)(lds + LDS_BYTES - 128);
            for (;;) {
                if (wv == 0 && __builtin_amdgcn_mbcnt_hi(~0u, __builtin_amdgcn_mbcnt_lo(~0u, 0u)) == 0) qslot[0] = (int)__hip_atomic_fetch_add(ctr, 1u, __ATOMIC_RELAXED, __HIP_MEMORY_SCOPE_AGENT);
                __syncthreads();
                const int u = qslot[0];
                __syncthreads();
                if (u >= N_UNITS) break;
                if (u < N_HG) hg_state_unit(p, layer, u, lds, wv);
                else compress_unit(p, layer, u - N_HG, lds, wv);
            }
        }
        GRID_BAR();
        {
            constexpr int N_HG = 48 * (NCHUNK / HG_G), N_UNITS = 512 + N_HG + 512;
            unsigned* ctr = (unsigned*)(p.ws + WS_CTL + 32768) + 64 * layer;
            LAS int* qslot = (LAS int*)(lds + LDS_BYTES - 128);
            for (;;) {
                if (wv == 0 && __builtin_amdgcn_mbcnt_hi(~0u, __builtin_amdgcn_mbcnt_lo(~0u, 0u)) == 0) qslot[0] = (int)__hip_atomic_fetch_add(ctr, 1u, __ATOMIC_RELAXED, __HIP_MEMORY_SCOPE_AGENT);
                __syncthreads();
                const int u = qslot[0];
                __syncthreads();
                if (u >= N_UNITS) break;
                if (u < 512) { for (int rep = 0; rep < DUMMY_NSA; ++rep) nsa_unit(p, u, lds, wv, DUMMY_SKIP); for (int rep = 0; rep < REP_NSA; ++rep) nsa_unit(p, u, lds, wv); }
                else if (u < 512 + N_HG) { for (int rep = 0; rep < REP_HG; ++rep) hg_out_unit(p, layer, u - 512, lds, wv); }
                else { for (int rep = 0; rep < REP_SB; ++rep) sb_unit(p, u - 512 - N_HG, lds, wv); }
            }
        }
        GRID_BAR();
        {
            size_t zoff_ = 0; asm volatile("" : "+s"(zoff_)); unsigned char* ws = p.ws + zoff_; h16* MIX = (h16*)(ws + WS_MIX); h16* Y16 = (h16*)(ws + WS_H);
            pg8::Gemm g{(const pg8::bf16_t*)MIX, (const pg8::bf16_t*)((h16*)(ws + WS_WOUTT) + (size_t)layer * 1024 * 1024), MTOK, DM, DM};
            pg8::StaticOrder S; S.init(MTOK, DM, gridDim.x, blockIdx.x);
            pg8::EpiY<true> E{(const void*)(ws + WS_XH), Y16, ALPHA}; pg8::gemm_phase<pg8::EpiY<true>, pg8::StaticOrder, true, true>(lds, g, S, E, wv);
        }
        GRID_BAR();
        ln_phase(p, layer, wv);
        if (layer + 1 < DEPTH) GRID_BAR();
    }
}

extern "C" void kernel_launch(void* const* d_in, const int* in_sizes, int n_in, void* d_out, int out_size, void* d_ws, size_t ws_size, hipStream_t stream) {
    static int grid = 0;
    if (grid == 0) {
        if (n_in != 13 || ws_size < WS_END) { fprintf(stderr, "kernel_launch: unexpected n_in %d or ws_size %zu (< %zu)\n", n_in, ws_size, (size_t)WS_END); grid = -1; return; }
        int dev = 0, cus = 0, per_cu = 0;
        hipGetDevice(&dev); hipDeviceGetAttribute(&cus, hipDeviceAttributeMultiprocessorCount, dev);
        if (hipFuncSetAttribute((const void*)mega, hipFuncAttributeMaxDynamicSharedMemorySize, LDS_BYTES) != hipSuccess) { fprintf(stderr, "kernel_launch: hipFuncSetAttribute failed\n"); grid = -1; return; }
        if (hipOccupancyMaxActiveBlocksPerMultiprocessor(&per_cu, (const void*)mega, 512, LDS_BYTES) != hipSuccess || per_cu < 1) { fprintf(stderr, "kernel_launch: occupancy query failed (%d)\n", per_cu); (void)hipGetLastError(); per_cu = 1; }
        grid = cus * per_cu;
        fprintf(stderr, "kernel_launch: cus %d per_cu %d grid %d\n", cus, per_cu, grid);
    }
    if (grid < 0) return;
    hipMemsetAsync((char*)d_ws + WS_CTL, 0, CTL_BYTES, stream);
    Params p{};
    for (int i = 0; i < 13; ++i) p.in[i] = (const float*)d_in[i];
    p.out = (float*)d_out; p.ws = (unsigned char*)d_ws;
    void* args[] = {&p};
    hipError_t e = hipLaunchCooperativeKernel((const void*)mega, dim3(grid), dim3(512), args, LDS_BYTES, stream);
    if (e != hipSuccess) fprintf(stderr, "cooperative launch failed: %s (grid %d)\n", hipGetErrorString(e), grid);
}
```
